# Optimizing an MI355X kernel written in HIP

```python
import math
import jax, jax.numpy as jnp
from jax import lax
import numpy as np

D_MODEL = 1024
BATCH = 8
SEQ = 2048
DEPTH = 2

N_EVEN = (DEPTH + 1) // 2
N_ODD = DEPTH // 2
NORM_EPS = 1e-6

MIX_WIDTH = D_MODEL
A_WIDTH = D_MODEL // 2
A_HEAD_DIM = 128
A_HEADS = A_WIDTH // A_HEAD_DIM
A_CHUNK = 32
B_WIDTH = MIX_WIDTH - A_WIDTH
B_HEAD_DIM = 64
B_HEADS = B_WIDTH // B_HEAD_DIM
B_DECAY_LORA = 64
B_AAA_LORA = 64
B_GATE_LORA = 128
B_LN_EPS = 1e-5 * B_HEAD_DIM
A_SIZES = [A_WIDTH] * 5
B_SIZES = [B_WIDTH] * 3 + [B_DECAY_LORA, B_DECAY_LORA, B_AAA_LORA, B_GATE_LORA]
A_COLS = sum(A_SIZES)
B_COLS = sum(B_SIZES)
AB_COLS = A_COLS + B_COLS

C_HEADS = 8
C_HEAD_DIM = 64
C_QK_WIDTH = C_HEADS * 2 * C_HEAD_DIM
C_V_WIDTH = C_HEADS * 2 * C_HEAD_DIM
C_QKV_COLS = 2 * C_QK_WIDTH + C_V_WIDTH
Q_BLOCK = 128
REL_BUCKETS = 32
REL_MAX_DISTANCE = 128

N_EXPERTS = 32
TOP_K = 4
D_EXPERT = D_MODEL
SWIGLU_LIMIT = 7.0
SWIGLU_ALPHA = 1.702

kernel_name = 'hybrid_hgrn2_rwkv7_diffattn_moe_encoder'


def _split(t, sizes):
    return jnp.split(t, [int(v) for v in np.cumsum(sizes)[:-1]], axis=-1)


def _rmsnorm(x, g, eps=NORM_EPS):
    xf = x.astype(jnp.float32)
    y = xf * lax.rsqrt(jnp.mean(xf * xf, axis=-1, keepdims=True) + eps)
    return (y * g.astype(jnp.float32)).astype(x.dtype)


def _modulate(x, g, shift, scale):
    return _rmsnorm(x, g) * (1.0 + scale) + shift


def _centred_shift(t):
    prev = jnp.pad(t[:, :-1], ((0, 0), (1, 0), (0, 0)))
    nxt = jnp.pad(t[:, 1:], ((0, 0), (0, 1), (0, 0)))
    return 0.5 * (prev + nxt)


def _gla_chunked(q, k, v, log_f):
    B_, S_, H_, dk = q.shape
    dv = v.shape[-1]
    n = S_ // A_CHUNK
    rs = lambda t: t.reshape(B_, n, A_CHUNK, H_, t.shape[-1])
    q, k, v, log_f = rs(q), rs(k), rs(v), rs(log_f)
    b = jnp.cumsum(log_f, axis=2)
    b_last = b[:, :, -1:]
    q_in = q * jnp.exp(b)
    k_in = k * jnp.exp(-b)
    k_st = k * jnp.exp(b_last - b)
    scores = jnp.einsum('bnthk,bnshk->bnhts', q_in, k_in)
    mask = jnp.tril(jnp.ones((A_CHUNK, A_CHUNK), dtype=bool))
    o_intra = jnp.einsum('bnhts,bnshv->bnthv', jnp.where(mask, scores, 0.0), v)
    d_state = jnp.einsum('bnshk,bnshv->bnhkv', k_st, v)
    chunk_decay = jnp.exp(b_last[:, :, 0])

    def step(state, inp):
        ds, dec = inp
        return dec[..., None] * state + ds, state

    s0 = jnp.zeros((B_, H_, dk, dv), jnp.float32)
    _, s_in = lax.scan(step, s0, (jnp.moveaxis(d_state, 1, 0), jnp.moveaxis(chunk_decay, 1, 0)))
    s_in = jnp.moveaxis(s_in, 0, 1)
    o_inter = jnp.einsum('bnthk,bnhkv->bnthv', q_in, s_in)
    return (o_intra + o_inter).reshape(B_, S_, H_, dv)


def _hgrn2_mix(p_a, lb, norm_g):
    B_, S_, _ = p_a.shape
    q, f_fwd, f_bwd, i, g = _split(p_a.astype(jnp.float32), A_SIZES)
    q = jax.nn.silu(q)
    heads = lambda t: t.reshape(B_, S_, A_HEADS, A_HEAD_DIM)

    def direction(f_logit, lb_dir, rev):
        fg = lb_dir + (1.0 - lb_dir) * jax.nn.sigmoid(f_logit)
        args = [heads(t) for t in (q, 1.0 - fg, i, jnp.log(fg))]
        if rev:
            args = [jnp.flip(t, 1) for t in args]
        o = _gla_chunked(*args)
        return jnp.flip(o, 1) if rev else o

    o = direction(f_fwd, lb[0], False) + direction(f_bwd, lb[1], True)
    o = _rmsnorm(o, norm_g) * jax.nn.silu(heads(g))
    return o.reshape(B_, S_, A_WIDTH)


def _rwkv7_mix(p_b, w0, w2, a0, a2, g2, k_k, k_a, r_k, ln_g, ln_b):
    B_, S_, _ = p_b.shape
    r, k, v, wlo_f, wlo_b, alo, glo = _split(p_b.astype(jnp.float32), B_SIZES)
    wlo = jnp.stack([wlo_f, wlo_b], 0)
    w = -jax.nn.softplus(-(w0[:, None, None, :] + jnp.einsum('nbsl,nlc->nbsc', jnp.tanh(wlo), w2))) - 0.5
    decay = jnp.exp(-jnp.exp(w))
    a = jax.nn.sigmoid(a0 + alo @ a2)
    g = jax.nn.sigmoid(glo) @ g2
    heads = lambda t: t.reshape(B_, S_, B_HEADS, B_HEAD_DIM)
    kk = heads(k * k_k)
    kk = kk / jnp.maximum(jnp.sqrt(jnp.sum(kk * kk, axis=-1, keepdims=True)), 1e-12)
    k = k * (1.0 + (a - 1.0) * k_a)
    r, k, v, a = heads(r), heads(k), heads(v), heads(a)
    decay = decay.reshape(2, B_, S_, B_HEADS, B_HEAD_DIM)

    both = lambda t: jnp.stack([t, jnp.flip(t, 1)], 0)
    time_major = lambda t: jnp.moveaxis(t, 2, 0)
    w_dir = jnp.stack([decay[0], jnp.flip(decay[1], 1)], 0)
    xs = (time_major(both(r)), time_major(w_dir), time_major(both(k)),
          time_major(both(v)), time_major(both(kk)), time_major(both(kk * a)))

    def step(state, inp):
        r_t, w_t, k_t, v_t, kk_t, b_t = inp
        sa = jnp.einsum('...vk,...k->...v', state, -kk_t)
        state = (state * w_t[..., None, :] + sa[..., :, None] * b_t[..., None, :]
                 + v_t[..., :, None] * k_t[..., None, :])
        return state, jnp.einsum('...vk,...k->...v', state, r_t)

    s0 = jnp.zeros((2, B_, B_HEADS, B_HEAD_DIM, B_HEAD_DIM), jnp.float32)
    _, y = lax.scan(step, s0, xs)
    y = jnp.moveaxis(y, 0, 2)
    y = y[0] + jnp.flip(y[1], 1)
    mean = jnp.mean(y, axis=-1, keepdims=True)
    var = jnp.mean(jnp.square(y - mean), axis=-1, keepdims=True)
    yn = (y - mean) * lax.rsqrt(var + B_LN_EPS)
    yn = yn * ln_g.reshape(B_HEADS, B_HEAD_DIM) + ln_b.reshape(B_HEADS, B_HEAD_DIM)
    bonus = jnp.sum(r * k * r_k.reshape(B_HEADS, B_HEAD_DIM), axis=-1, keepdims=True) * v
    return (yn + bonus).reshape(B_, S_, B_WIDTH) * g


def _ab_mixer(h, w_in, w_out, lb, hgrn_norm_g, mu, w0, w2, a0, a2, g2, k_k, k_a, r_k, ln_g, ln_b):
    p = h @ w_in
    p_a, p_b = p[..., :A_COLS], p[..., A_COLS:]
    p_b = p_b + mu * (_centred_shift(p_b) - p_b)
    y = jnp.concatenate([_hgrn2_mix(p_a, lb, hgrn_norm_g),
                         _rwkv7_mix(p_b, w0, w2, a0, a2, g2, k_k, k_a, r_k, ln_g, ln_b)], axis=-1)
    return y @ w_out


def _t5_bucket(rel):
    nb = REL_BUCKETS // 2
    max_exact = nb // 2
    bucket = jnp.where(rel > 0, nb, 0)
    n = jnp.abs(rel)
    nf = jnp.maximum(n, 1).astype(jnp.float32)
    large = max_exact + (jnp.log(nf / max_exact) / math.log(REL_MAX_DISTANCE / max_exact)
                         * (nb - max_exact)).astype(jnp.int32)
    large = jnp.minimum(large, nb - 1)
    return bucket + jnp.where(n < max_exact, n, large)


def _diff_attention(h, w_in, w_out, lam, subln_g, rel_table, layer_idx):
    B_, S_, _ = h.shape
    qkv = h @ w_in
    q, k, v = _split(qkv, [C_QK_WIDTH, C_QK_WIDTH, C_V_WIDTH])
    q = q.reshape(B_, S_, C_HEADS, 2, C_HEAD_DIM)
    k = k.reshape(B_, S_, C_HEADS, 2, C_HEAD_DIM)
    v = v.reshape(B_, S_, C_HEADS, 2 * C_HEAD_DIM)
    lam = lam.astype(jnp.float32)
    lam_init = 0.8 - 0.6 * math.exp(-0.3 * layer_idx)
    lam_full = jnp.exp(jnp.sum(lam[0] * lam[1])) - jnp.exp(jnp.sum(lam[2] * lam[3])) + lam_init
    scale = C_HEAD_DIM ** -0.5
    nb = S_ // Q_BLOCK
    q_blocks = jnp.moveaxis(q.reshape(B_, nb, Q_BLOCK, C_HEADS, 2, C_HEAD_DIM), 1, 0)
    pos = jnp.arange(S_, dtype=jnp.int32)
    q_pos = pos.reshape(nb, Q_BLOCK)

    def block(args):
        qb, qp = args
        bucket = _t5_bucket(pos[None, :] - qp[:, None])
        bias = jnp.transpose(rel_table[bucket], (2, 0, 1)).astype(jnp.float32)
        logits = jnp.einsum('bqhmd,bkhmd->bmhqk', qb, k).astype(jnp.float32) * scale + bias
        p = jax.nn.softmax(logits, axis=-1)
        attn = p[:, 0] - lam_full * p[:, 1]
        return jnp.einsum('bhqk,bkhv->bqhv', attn.astype(v.dtype), v)

    o = lax.map(block, (q_blocks, q_pos))
    o = jnp.moveaxis(o, 0, 1).reshape(B_, S_, C_HEADS, 2 * C_HEAD_DIM)
    o = _rmsnorm(o, subln_g) * (1.0 - lam_init)
    return o.reshape(B_, S_, C_V_WIDTH) @ w_out


def _moe_ffn(h, router_w, router_b, w1, b1, w2, b2):
    B_, S_, D_ = h.shape
    t = h.reshape(-1, D_)
    logits = (t @ router_w + router_b).astype(jnp.float32)
    top_val, top_idx = lax.top_k(logits, TOP_K)
    top_w = jax.nn.softmax(top_val, axis=-1)
    gates = jnp.sum(jax.nn.one_hot(top_idx, N_EXPERTS, dtype=jnp.float32) * top_w[..., None], axis=1)

    def expert_step(acc, params):
        w1_e, b1_e, w2_e, b2_e, gate_e = params
        hh = t @ w1_e + b1_e
        x_glu = jnp.minimum(hh[:, ::2], SWIGLU_LIMIT)
        x_lin = jnp.clip(hh[:, 1::2], -SWIGLU_LIMIT, SWIGLU_LIMIT)
        act = x_glu * jax.nn.sigmoid(SWIGLU_ALPHA * x_glu) * (x_lin + 1.0)
        out = act @ w2_e + b2_e
        return acc + gate_e[:, None] * out.astype(jnp.float32), None

    acc0 = jnp.zeros((t.shape[0], D_), jnp.float32)
    acc, _ = lax.scan(expert_step, acc0, (w1, b1, w2, b2, gates.T))
    return acc.reshape(B_, S_, D_)


def setup_inputs(seed: int = 0) -> dict:
    key = jax.random.key(seed)
    keys = iter(jax.random.split(key, 48))

    def nrm(shape, scale):
        return jax.random.normal(next(keys), shape, jnp.float32) * scale

    def unif(shape):
        return jax.random.uniform(next(keys), shape, jnp.float32)

    L, NE, NO, D = DEPTH, N_EVEN, N_ODD, D_MODEL
    return {
        'x': nrm((BATCH, SEQ, D), 1.0),
        'c': nrm((BATCH, D), 1.0),
        'ada_w': nrm((L, D, 6 * D), 0.5 * D ** -0.5),
        'ada_b': nrm((L, 6 * D), 0.02),
        'norm_mix_g': 1.0 + nrm((L, D), 0.02),
        'norm_ffn_g': 1.0 + nrm((L, D), 0.02),
        'router_w': nrm((L, D, N_EXPERTS), D ** -0.5),
        'router_b': nrm((L, N_EXPERTS), 0.01),
        'moe_w1': nrm((L, N_EXPERTS, D, 2 * D_EXPERT), D ** -0.5),
        'moe_b1': nrm((L, N_EXPERTS, 2 * D_EXPERT), 0.02),
        'moe_w2': nrm((L, N_EXPERTS, D_EXPERT, D), D_EXPERT ** -0.5),
        'moe_b2': nrm((L, N_EXPERTS, D), 0.02),
        'ab_w_in': nrm((NE, D, AB_COLS), D ** -0.5),
        'ab_w_out': nrm((NE, MIX_WIDTH, D), MIX_WIDTH ** -0.5),
        'hgrn_lb': nrm((2, NE + 1, A_WIDTH), 0.5),
        'hgrn_norm_g': 1.0 + nrm((NE, A_HEAD_DIM), 0.02),
        'rwkv_mu': unif((NE, B_COLS)),
        'rwkv_w0': -2.0 + nrm((NE, 2, B_WIDTH), 0.5),
        'rwkv_w2': nrm((NE, 2, B_DECAY_LORA, B_WIDTH), 0.1),
        'rwkv_a0': nrm((NE, B_WIDTH), 0.5),
        'rwkv_a2': nrm((NE, B_AAA_LORA, B_WIDTH), B_AAA_LORA ** -0.5),
        'rwkv_g2': nrm((NE, B_GATE_LORA, B_WIDTH), B_GATE_LORA ** -0.5),
        'rwkv_k_k': 0.85 + nrm((NE, B_WIDTH), 0.05),
        'rwkv_k_a': 1.0 + nrm((NE, B_WIDTH), 0.05),
        'rwkv_r_k': nrm((NE, B_WIDTH), 0.1),
        'rwkv_ln_g': 1.0 + nrm((NE, B_WIDTH), 0.02),
        'rwkv_ln_b': nrm((NE, B_WIDTH), 0.02),
        'attn_w_in': nrm((NO, D, C_QKV_COLS), D ** -0.5),
        'attn_w_out': nrm((NO, C_V_WIDTH, D), C_V_WIDTH ** -0.5),
        'attn_lambda': nrm((NO, 4, C_HEAD_DIM), 0.1),
        'attn_subln_g': 1.0 + nrm((NO, 2 * C_HEAD_DIM), 0.02),
        'rel_bias_table': nrm((REL_BUCKETS, C_HEADS), 0.5),
        'final_norm_g': 1.0 + nrm((D,), 0.02),
    }


def reference(x, c, ada_w, ada_b, norm_mix_g, norm_ffn_g, router_w, router_b, moe_w1, moe_b1,
              moe_w2, moe_b2, ab_w_in, ab_w_out, hgrn_lb, hgrn_norm_g, rwkv_mu, rwkv_w0, rwkv_w2,
              rwkv_a0, rwkv_a2, rwkv_g2, rwkv_k_k, rwkv_k_a, rwkv_r_k, rwkv_ln_g, rwkv_ln_b,
              attn_w_in, attn_w_out, attn_lambda, attn_subln_g, rel_bias_table, final_norm_g):
    cond = jax.nn.silu(c.astype(jnp.float32))
    lb_all = jnp.cumsum(jax.nn.softmax(hgrn_lb.astype(jnp.float32), axis=1), axis=1)
    for layer in range(DEPTH):
        mod = cond @ ada_w[layer].astype(jnp.float32) + ada_b[layer]
        sh_m, sc_m, g_m, sh_f, sc_f, g_f = [m[:, None, :] for m in jnp.split(mod, 6, axis=-1)]
        h = _modulate(x, norm_mix_g[layer], sh_m, sc_m)
        j = layer // 2
        if layer % 2 == 0:
            y = _ab_mixer(h, ab_w_in[j], ab_w_out[j], lb_all[:, j], hgrn_norm_g[j], rwkv_mu[j],
                          rwkv_w0[j], rwkv_w2[j], rwkv_a0[j], rwkv_a2[j], rwkv_g2[j], rwkv_k_k[j],
                          rwkv_k_a[j], rwkv_r_k[j], rwkv_ln_g[j], rwkv_ln_b[j])
        else:
            y = _diff_attention(h, attn_w_in[j], attn_w_out[j], attn_lambda[j], attn_subln_g[j],
                                rel_bias_table, layer)
        x = x + (g_m * y).astype(x.dtype)
        h = _modulate(x, norm_ffn_g[layer], sh_f, sc_f)
        y = _moe_ffn(h, router_w[layer], router_b[layer], moe_w1[layer], moe_b1[layer],
                     moe_w2[layer], moe_b2[layer])
        x = x + (g_f * y).astype(x.dtype)
    return _rmsnorm(x, final_norm_g)
```

```cpp
#include <hip/hip_runtime.h>
#include <cstdio>
#include <cstdint>
#define MK_N_LAUNCHES 1
namespace pg8 {
#define PG8_LAS __attribute__((address_space(3)))
typedef unsigned short bf16_t;
typedef short bf16x8 __attribute__((ext_vector_type(8)));
typedef float f32x4 __attribute__((ext_vector_type(4)));
typedef unsigned u32x4 __attribute__((ext_vector_type(4)));
constexpr int BM = 256, BK = 64, HALF = 128, HTB = HALF * BK * 2  , STAGE_BYTES = 8 * HTB, NXCD = 8, WGM = 8;

__host__ __device__ __forceinline__ int lds_byte(int r, int c) { const int st = (r >> 4) * 2 + (c >> 5), rr = r & 15, cc = c & 31, ob = rr * 64 + cc * 2; return st * 1024 + (ob ^ (((ob >> 9) & 1) << 5)); }
__host__ __device__ __forceinline__ void stage_rc(int b, int& R, int& C) { const int st = b / 1024, sb = b % 1024, swz = sb ^ (((sb >> 9) & 1) << 5); R = (st >> 1) * 16 + swz / 64; C = (st & 1) * 32 + (swz % 64) / 2; }
__host__ __device__ __forceinline__ int perm32(int rho) { const int n = rho >> 4, i = rho & 15; return 8 * (i >> 2) + 4 * n + (i & 3); }

struct Unit { int pm, pn; };
struct Gemm { const bf16_t* A; const bf16_t* Bt; int M, N, K; };

struct StaticOrder {
    int nM, nN, nwg, G, c;
    __host__ __device__ void init(int M, int N, int G_, int c_) { nM = M / BM; nN = N / BM; nwg = nM * nN; G = G_; c = c_; }
    __host__ __device__ bool next(int i, Unit& u) const {
        const long L = (long)i * G + c; if (L >= nwg) return false;
        int wgid = (int)L; { const int q = nwg / NXCD, r = nwg % NXCD, xcd = wgid % NXCD, off = wgid / NXCD; wgid = (xcd < r ? xcd * (q + 1) : r * (q + 1) + (xcd - r) * q) + off; }
        const int nig = WGM * nN, gid = wgid / nig, fm = gid * WGM, gsz = (nM - fm) < WGM ? (nM - fm) : WGM;
        u.pm = fm + ((wgid % nig) % gsz); u.pn = (wgid % nig) / gsz; return true;
    }
    __device__ __forceinline__ void a_ready(const Unit&) const {}
    __device__ __forceinline__ void done(const Unit&) const {}
};

__device__ __forceinline__ unsigned cvt_pk_bf16(float lo, float hi) { unsigned r; asm volatile("v_cvt_pk_bf16_f32 %0, %1, %2" : "=v"(r) : "v"(lo), "v"(hi)); return r; }
typedef float f32x2 __attribute__((ext_vector_type(2)));
__device__ __forceinline__ f32x2 gelu_pk(f32x2 v) {
    const f32x2 av = __builtin_elementwise_abs(v), d = av * 0.2316418882f + 1.0f;
    f32x2 t; t.x = __builtin_amdgcn_rcpf(d.x); t.y = __builtin_amdgcn_rcpf(d.y);
    f32x2 q = t * 0.5307027145f + (-0.7265760135f); q = q * t + 0.7107068705f; q = q * t + (-0.142248368f); q = q * t + 0.127414796f; q = q * t;
    const f32x2 s = (v * v) * (-0.72134752044f);
    f32x2 e; e.x = __builtin_amdgcn_exp2f(s.x); e.y = __builtin_amdgcn_exp2f(s.y);
    const f32x2 m = v * (q * e), r = v - m;
    f32x2 o; o.x = v.x < 0.f ? m.x : r.x; o.y = v.y < 0.f ? m.y : r.y; return o;
}

template <int ACT  > struct EpiBf16 {
    static constexpr bool PERM = true, AFTER_DRAIN = false; static_assert(ACT == 0 || ACT == 1, "EpiBf16: ACT is 0 (none) or 1 (gelu_pk)");
    bf16_t* O; int ldc; const float* bias; int split_cols; size_t split_stride; float scale0;
    __device__ __forceinline__ void operator()(const f32x4 (&acc)[2][2][4][2], const Unit& u, int wr, int wc, int fr, int fq) const {
        const int row0 = u.pm * BM + wr * 64 + fr; int colt = u.pn * BM; bf16_t* base = O;
        float sc = 1.f; if (split_cols) { const int t = colt / split_cols; base += (size_t)t * split_stride; colt -= t * split_cols; if (t == 0) sc = scale0; }
        const int col0 = colt + wc * 32 + 8 * fq, bcol0 = u.pn * BM + wc * 32 + 8 * fq;
        f32x4 bv[2][2];
#pragma unroll
        for (int bj = 0; bj < 2; ++bj)
#pragma unroll
            for (int n = 0; n < 2; ++n) bv[bj][n] = bias ? *(const f32x4*)(bias + bcol0 + bj * HALF + 4 * n) : (f32x4){0.f, 0.f, 0.f, 0.f};
#pragma unroll
        for (int ai = 0; ai < 2; ++ai)
#pragma unroll
            for (int m = 0; m < 4; ++m) { bf16_t* rowp = base + (size_t)(row0 + ai * HALF + m * 16) * ldc + col0;
#pragma unroll
                for (int bj = 0; bj < 2; ++bj) { f32x4 v0 = acc[ai][bj][m][0] + bv[bj][0], v1 = acc[ai][bj][m][1] + bv[bj][1];
                    if (ACT == 1) { f32x2 a = gelu_pk((f32x2){v0[0], v0[1]}), b = gelu_pk((f32x2){v0[2], v0[3]}), c = gelu_pk((f32x2){v1[0], v1[1]}), d = gelu_pk((f32x2){v1[2], v1[3]});
                        v0 = (f32x4){a.x, a.y, b.x, b.y}; v1 = (f32x4){c.x, c.y, d.x, d.y}; }
                    v0 = v0 * sc; v1 = v1 * sc; u32x4 w; w.x = cvt_pk_bf16(v0[0], v0[1]); w.y = cvt_pk_bf16(v0[2], v0[3]); w.z = cvt_pk_bf16(v1[0], v1[1]); w.w = cvt_pk_bf16(v1[2], v1[3]);
                    *(u32x4*)(rowp + bj * HALF) = w; } }
    }
};
struct EpiResGate {
    static constexpr bool PERM = false, AFTER_DRAIN = false;
    const float* base; float* out; const float* gate;
    __device__ __forceinline__ void operator()(const f32x4 (&acc)[2][2][4][2], const Unit& u, int wr, int wc, int fr, int fq) const {
        const int col0 = u.pn * BM + wc * 32 + 4 * fq; const int b = u.pm >> 3;
        f32x4 gv[2][2];
#pragma unroll
        for (int bj = 0; bj < 2; ++bj)
#pragma unroll
            for (int n = 0; n < 2; ++n) gv[bj][n] = *(const f32x4*)(gate + (size_t)b * 6144 + col0 + bj * HALF + n * 16);
#pragma unroll
        for (int ai = 0; ai < 2; ++ai)
#pragma unroll
            for (int m = 0; m < 4; ++m) { const size_t off = (size_t)(u.pm * BM + ai * HALF + wr * 64 + m * 16 + fr) * 1024 + col0;
#pragma unroll
                for (int bj = 0; bj < 2; ++bj)
#pragma unroll
                    for (int n = 0; n < 2; ++n) { const f32x4 bs = *(const f32x4*)(base + off + bj * HALF + n * 16);
                        *(f32x4*)(out + off + bj * HALF + n * 16) = bs + gv[bj][n] * acc[ai][bj][m][n]; } }
    }
};
struct EpiSwiglu {
    static constexpr bool PERM = true, AFTER_DRAIN = false;
    bf16_t* O; const float* bias;
    __device__ __forceinline__ void operator()(const f32x4 (&acc)[2][2][4][2], const Unit& u, int wr, int wc, int fr, int fq) const {
        const int row0 = u.pm * BM + wr * 64 + fr; const int bcol0 = u.pn * BM + wc * 32 + 8 * fq;
        const int ocol0 = (u.pn & 7) * 128 + wc * 16 + 4 * fq;
        f32x4 bv[2][2];
#pragma unroll
        for (int bj = 0; bj < 2; ++bj)
#pragma unroll
            for (int n = 0; n < 2; ++n) bv[bj][n] = *(const f32x4*)(bias + bcol0 + bj * HALF + 4 * n);
#pragma unroll
        for (int ai = 0; ai < 2; ++ai)
#pragma unroll
            for (int m = 0; m < 4; ++m) { bf16_t* rowp = O + (size_t)(row0 + ai * HALF + m * 16) * 1024 + ocol0;
#pragma unroll
                for (int bj = 0; bj < 2; ++bj) { const f32x4 v0 = acc[ai][bj][m][0] + bv[bj][0], v1 = acc[ai][bj][m][1] + bv[bj][1];
                    float g[4] = {v0[0], v0[2], v1[0], v1[2]}, l[4] = {v0[1], v0[3], v1[1], v1[3]}, a[4];
#pragma unroll
                    for (int i = 0; i < 4; ++i) { const float xg = fminf(g[i], 7.0f), xl = fminf(fmaxf(l[i], -7.0f), 7.0f);
                        const float e = __builtin_amdgcn_exp2f(xg * (-1.702f * 1.4426950408889634f)); a[i] = xg * __builtin_amdgcn_rcpf(1.0f + e) * (xl + 1.0f); }
                    typedef unsigned u32x2 __attribute__((ext_vector_type(2)));
                    u32x2 w; w.x = cvt_pk_bf16(a[0], a[1]); w.y = cvt_pk_bf16(a[2], a[3]);
                    *(u32x2*)(rowp + bj * 64) = w; } }
    }
};
struct EpiMoeOut {
    static constexpr bool PERM = true, AFTER_DRAIN = false;
    bf16_t* O; const float* bias; const float* rgate;
    __device__ __forceinline__ void operator()(const f32x4 (&acc)[2][2][4][2], const Unit& u, int wr, int wc, int fr, int fq) const {
        const int row0 = u.pm * BM + wr * 64 + fr; const int bcol0 = u.pn * BM + wc * 32 + 8 * fq;
        const int ocol0 = (u.pn & 3) * BM + wc * 32 + 8 * fq;
        f32x4 bv[2][2];
#pragma unroll
        for (int bj = 0; bj < 2; ++bj)
#pragma unroll
            for (int n = 0; n < 2; ++n) bv[bj][n] = *(const f32x4*)(bias + bcol0 + bj * HALF + 4 * n);
#pragma unroll
        for (int ai = 0; ai < 2; ++ai)
#pragma unroll
            for (int m = 0; m < 4; ++m) { const int row = row0 + ai * HALF + m * 16; const float gt = rgate[row]; bf16_t* rowp = O + (size_t)row * 1024 + ocol0;
#pragma unroll
                for (int bj = 0; bj < 2; ++bj) { const f32x4 v0 = (acc[ai][bj][m][0] + bv[bj][0]) * gt, v1 = (acc[ai][bj][m][1] + bv[bj][1]) * gt;
                    u32x4 w; w.x = cvt_pk_bf16(v0[0], v0[1]); w.y = cvt_pk_bf16(v0[2], v0[3]); w.z = cvt_pk_bf16(v1[0], v1[1]); w.w = cvt_pk_bf16(v1[2], v1[3]);
                    *(u32x4*)(rowp + bj * HALF) = w; } }
    }
};
struct GroupedOrder {
    int total, G, c, NT; const PG8_LAS int* tile_exp;
    __device__ __forceinline__ bool next(int i, Unit& u) const { const int L = i * G + c; if (L >= total) return false; const int mt = L / NT, nt = L - mt * NT; u.pm = mt; u.pn = tile_exp[mt] * NT + nt; return true; }
    __device__ __forceinline__ void a_ready(const Unit&) const {}
    __device__ __forceinline__ void done(const Unit&) const {}
};
template <class Epi, class Sched, bool ALIGN_EPI = false, bool SP2 = false>
__device__ __forceinline__ void gemm_phase(PG8_LAS unsigned char* lds, const Gemm g, const Sched& S, const Epi& E) {
    const int tid = threadIdx.x, wid = __builtin_amdgcn_readfirstlane(tid >> 6), lane = tid & 63, wr = wid >> 2, wc = wid & 3, fr = lane & 15, fq = lane >> 4;
    const int K = g.K, nt = K / BK;
    unsigned voffA[2], voffB[2];
#pragma unroll
    for (int i = 0; i < 2; ++i) { int R, C; stage_rc(tid * 16 + i * 8192, R, C); const int Rb = Epi::PERM ? ((R & ~31) + perm32(R & 31)) : R;
        voffA[i] = (unsigned)(R * K + C) * 2u; voffB[i] = (unsigned)(Rb * K + C) * 2u; }
    const size_t kstep = (size_t)(BK * 2);
    const size_t hstep = (size_t)HALF * K * 2;
    const size_t tstep = 2 * hstep;
    const unsigned ldsw = (unsigned)wid * 1024u;
    const int aoff = lds_byte(wr * 64 + fr, fq * 8), boff = lds_byte(wc * 32 + fr, fq * 8);
#define PG8_SA(b, h) (((b) * 2 + (h)) * HTB)
#define PG8_SB(b, h) ((4 + (b) * 2 + (h)) * HTB)
#define PG8_STAGE(bufoff, gbase, voff) do { _Pragma("unroll") for (int _i = 0; _i < 2; ++_i) \
        __builtin_amdgcn_global_load_lds((const unsigned*)((const char*)(gbase) + (voff)[_i]), (PG8_LAS unsigned*)(lds + (bufoff) + ldsw + _i * 8192), 16, 0, 0); } while (0)
#define PG8_LDA(dst, b, h) do { _Pragma("unroll") for (int m = 0; m < 4; ++m) _Pragma("unroll") for (int k = 0; k < 2; ++k) dst[m][k] = *(const PG8_LAS bf16x8*)(lds + PG8_SA(b, h) + aoff + m * 2048 + k * 1024); } while (0)
#define PG8_LDB(dst, b, h) do { _Pragma("unroll") for (int n = 0; n < 2; ++n) _Pragma("unroll") for (int k = 0; k < 2; ++k) dst[n][k] = *(const PG8_LAS bf16x8*)(lds + PG8_SB(b, h) + boff + n * 2048 + k * 1024); } while (0)
#define PG8_MMA(ai, bj, At, Bt) do { __builtin_amdgcn_s_setprio(1); _Pragma("unroll") for (int m = 0; m < 4; ++m) _Pragma("unroll") for (int n = 0; n < 2; ++n) _Pragma("unroll") for (int k = 0; k < 2; ++k) \
        acc[ai][bj][m][n] = __builtin_amdgcn_mfma_f32_16x16x32_bf16(Bt[n][k], At[m][k], acc[ai][bj][m][n], 0, 0, 0); __builtin_amdgcn_s_setprio(0); } while (0)
#define PG8_WAIT_V(n) asm volatile("s_waitcnt vmcnt(" #n ")" ::: "memory")
#define PG8_WAIT_L(n) asm volatile("s_waitcnt lgkmcnt(" #n ")" ::: "memory")
#define PG8_BAR __builtin_amdgcn_s_barrier()
#define PG8_SCHED __builtin_amdgcn_sched_barrier(0)
    Unit cur, nxt; int ui = 0;
    if (!S.next(0, cur)) return;
    f32x4 acc[2][2][4][2];
#pragma unroll
    for (int a = 0; a < 2; ++a)
#pragma unroll
        for (int b = 0; b < 2; ++b)
#pragma unroll
            for (int m = 0; m < 4; ++m)
#pragma unroll
                for (int n = 0; n < 2; ++n) acc[a][b][m][n] = (f32x4){0.f, 0.f, 0.f, 0.f};
    bf16x8 At[4][2], B0[2][2], B1[2][2];
    const char* cA = (const char*)g.A + (size_t)cur.pm * tstep; const char* cB = (const char*)g.Bt + (size_t)cur.pn * tstep;
    S.a_ready(cur);
    if constexpr (SP2) {
        PG8_STAGE(PG8_SB(0, 0), cB, voffB); PG8_STAGE(PG8_SB(0, 1), cB + hstep, voffB); PG8_STAGE(PG8_SA(0, 0), cA, voffA); PG8_STAGE(PG8_SA(0, 1), cA + hstep, voffA);
        if (wr == 1) PG8_BAR;
        PG8_WAIT_V(2); PG8_BAR;
        PG8_STAGE(PG8_SB(1, 0), cB + kstep, voffB); PG8_STAGE(PG8_SA(1, 0), cA + kstep, voffA); PG8_STAGE(PG8_SB(1, 1), cB + hstep + kstep, voffB);
        PG8_WAIT_V(6); PG8_BAR;
    } else {
        PG8_STAGE(PG8_SB(0, 0), cB, voffB); PG8_STAGE(PG8_SA(0, 0), cA, voffA); PG8_STAGE(PG8_SB(0, 1), cB + hstep, voffB); PG8_STAGE(PG8_SA(0, 1), cA + hstep, voffA);
        if (wr == 1) PG8_BAR;
        PG8_WAIT_V(4); PG8_BAR;
        PG8_STAGE(PG8_SB(1, 0), cB + kstep, voffB); PG8_STAGE(PG8_SA(1, 0), cA + kstep, voffA); PG8_STAGE(PG8_SB(1, 1), cB + hstep + kstep, voffB);
        PG8_WAIT_V(6); PG8_BAR;
    }
    for (;;) {
        const bool has_next = S.next(ui + 1, nxt);
        const char* nA = has_next ? (const char*)g.A + (size_t)nxt.pm * tstep : cA; const char* nB = has_next ? (const char*)g.Bt + (size_t)nxt.pn * tstep : cB;
        for (int t = 0; t < nt; t += 2) {
            const bool last = (t == nt - 2);
            const char* a1 = cA + (size_t)(t + 1) * kstep;
            const char* a2 = last ? nA : cA + (size_t)(t + 2) * kstep; const char* b2 = last ? nB : cB + (size_t)(t + 2) * kstep;
            const char* a3 = a2 + kstep; const char* b3 = b2 + kstep;
            if (last && has_next) S.a_ready(nxt);
            if constexpr (SP2) {
            PG8_LDB(B0, 0, 0); PG8_LDB(B1, 0, 1); PG8_SCHED; PG8_LDA(At, 0, 0); PG8_STAGE(PG8_SA(1, 1), a1 + hstep, voffA);
            PG8_WAIT_V(8); PG8_WAIT_L(0); PG8_BAR; PG8_MMA(0, 0, At, B0); PG8_MMA(0, 1, At, B1); PG8_BAR; PG8_SCHED;
            PG8_LDA(At, 0, 1); PG8_STAGE(PG8_SB(0, 0), b2, voffB); PG8_STAGE(PG8_SB(0, 1), b2 + hstep, voffB); PG8_STAGE(PG8_SA(0, 0), a2, voffA);
            PG8_WAIT_V(8); PG8_WAIT_L(0); PG8_BAR; PG8_MMA(1, 0, At, B0); PG8_MMA(1, 1, At, B1); PG8_BAR; PG8_SCHED;
            PG8_LDB(B0, 1, 0); PG8_LDB(B1, 1, 1); PG8_SCHED; PG8_LDA(At, 1, 0); PG8_STAGE(PG8_SA(0, 1), a2 + hstep, voffA);
            PG8_WAIT_V(8); PG8_WAIT_L(0); PG8_BAR; PG8_MMA(0, 0, At, B0); PG8_MMA(0, 1, At, B1); PG8_BAR; PG8_SCHED;
            PG8_LDA(At, 1, 1); PG8_STAGE(PG8_SB(1, 0), b3, voffB); PG8_STAGE(PG8_SB(1, 1), b3 + hstep, voffB); PG8_STAGE(PG8_SA(1, 0), a3, voffA);
            PG8_WAIT_V(8); PG8_WAIT_L(0); PG8_BAR; PG8_MMA(1, 0, At, B0); PG8_MMA(1, 1, At, B1); PG8_BAR; PG8_SCHED;
            } else {
            PG8_LDB(B0, 0, 0); PG8_SCHED; PG8_LDA(At, 0, 0); PG8_STAGE(PG8_SA(1, 1), a1 + hstep, voffA);
            PG8_WAIT_L(8); PG8_BAR; PG8_WAIT_L(0); PG8_MMA(0, 0, At, B0); PG8_BAR; PG8_SCHED;
            PG8_LDB(B1, 0, 1); PG8_STAGE(PG8_SB(0, 0), b2, voffB);
            PG8_BAR; PG8_WAIT_L(0); PG8_MMA(0, 1, At, B1); PG8_BAR;
            PG8_LDA(At, 0, 1); PG8_STAGE(PG8_SA(0, 0), a2, voffA);
            PG8_BAR; PG8_WAIT_L(0); PG8_MMA(1, 0, At, B0); PG8_BAR; PG8_SCHED;
            PG8_STAGE(PG8_SB(0, 1), b2 + hstep, voffB);
            PG8_WAIT_V(6); PG8_BAR; PG8_MMA(1, 1, At, B1); PG8_BAR;
            PG8_LDB(B0, 1, 0); PG8_SCHED; PG8_LDA(At, 1, 0); PG8_STAGE(PG8_SA(0, 1), a2 + hstep, voffA);
            PG8_WAIT_L(8); PG8_BAR; PG8_WAIT_L(0); PG8_MMA(0, 0, At, B0); PG8_BAR; PG8_SCHED;
            PG8_LDB(B1, 1, 1); PG8_STAGE(PG8_SB(1, 0), b3, voffB);
            PG8_BAR; PG8_WAIT_L(0); PG8_MMA(0, 1, At, B1); PG8_BAR;
            PG8_LDA(At, 1, 1); PG8_STAGE(PG8_SA(1, 0), a3, voffA);
            PG8_BAR; PG8_WAIT_L(0); PG8_MMA(1, 0, At, B0); PG8_BAR; PG8_SCHED;
            PG8_STAGE(PG8_SB(1, 1), b3 + hstep, voffB);
            PG8_WAIT_V(6); PG8_BAR; PG8_MMA(1, 1, At, B1); PG8_BAR;
            }
        }
        if constexpr (ALIGN_EPI) { if (wr == 0) PG8_BAR; }
        if constexpr (!Epi::AFTER_DRAIN) { E(acc, cur, wr, wc, fr, fq); S.done(cur); }
        if (!has_next) break;
#pragma unroll
        for (int a = 0; a < 2; ++a)
#pragma unroll
            for (int b = 0; b < 2; ++b)
#pragma unroll
                for (int m = 0; m < 4; ++m)
#pragma unroll
                    for (int n = 0; n < 2; ++n) acc[a][b][m][n] = (f32x4){0.f, 0.f, 0.f, 0.f};
        cur = nxt; cA = nA; cB = nB; ++ui;
        if constexpr (ALIGN_EPI) { if (wr == 1) PG8_BAR; }
    }
    PG8_WAIT_V(0);
    if constexpr (!ALIGN_EPI) { if (wr == 0) PG8_BAR; }
    PG8_BAR;
    if constexpr (Epi::AFTER_DRAIN) { E.fused(acc, cur, wr, wc, fr, fq, lds, wid, lane); S.done(cur); }
#undef PG8_SA
#undef PG8_SB
#undef PG8_STAGE
#undef PG8_LDA
#undef PG8_LDB
#undef PG8_MMA
#undef PG8_WAIT_V
#undef PG8_WAIT_L
#undef PG8_BAR
#undef PG8_SCHED
}
}
#define GAS __attribute__((address_space(1)))
#define LAS __attribute__((address_space(3)))
typedef unsigned short bf16;
typedef unsigned v4u __attribute__((ext_vector_type(4)));
typedef float f32x4 __attribute__((ext_vector_type(4)));
typedef short bf16x8 __attribute__((ext_vector_type(8)));
typedef GAS unsigned gu32;
typedef GAS unsigned long long gu64;
#define RLX_AGENT __ATOMIC_RELAXED, __HIP_MEMORY_SCOPE_AGENT
#define LDS_WAIT() asm volatile("s_waitcnt lgkmcnt(0)" ::: "memory")
#define VM_WAIT() asm volatile("s_waitcnt vmcnt(0)" ::: "memory")
__device__ __forceinline__ unsigned long long rt() { return __builtin_amdgcn_s_memrealtime(); }
__device__ __forceinline__ unsigned f2bf(float f) { unsigned u = __builtin_bit_cast(unsigned, f); return (u + 0x7fffu + ((u >> 16) & 1u)) >> 16; }
__device__ __forceinline__ unsigned pk2(float lo, float hi) { return f2bf(lo) | (f2bf(hi) << 16); }

#define XB_TMO      128
#define XB_XCNT(j)  (256  + 64 * (j))
#define XB_XSUB(j)  (1280 + 64 * (j))
#define XB_XGEN(j)  (2304 + 64 * (j))
#define XB_TOP      3328
#define XB_TOPGEN   3392
#define XCD_BAR_WORDS 3456
#define XB_SPIN_CAP (1u << 18)

__device__ __forceinline__ unsigned xb_ld(unsigned* p)              { return __hip_atomic_load(p, __ATOMIC_RELAXED, __HIP_MEMORY_SCOPE_AGENT); }
__device__ __forceinline__ unsigned xb_add(unsigned* p, unsigned v) { return __hip_atomic_fetch_add(p, v, __ATOMIC_RELAXED, __HIP_MEMORY_SCOPE_AGENT); }
__device__ __forceinline__ unsigned xb_xcc_id() { return (unsigned)__builtin_amdgcn_s_getreg((3 << 11) | 20) & 0xFu; }
#define XB_SPIN(cond, bar) do { unsigned _sp = 0; while (cond) { __builtin_amdgcn_s_sleep(1); \
    if ((++_sp & 255u) == 0u) { if (xb_ld(&(bar)[XB_TMO])) break; if (_sp > XB_SPIN_CAP) { atomicAdd(&(bar)[XB_TMO], 1u); break; } } } } while (0)

struct XcdBarrier {
    unsigned* bar; unsigned x;
    volatile LAS unsigned* st;
};

__device__ __forceinline__ XcdBarrier xcd_barrier_post(unsigned* bar, volatile LAS unsigned* st) {
    XcdBarrier b; b.bar = bar; b.x = xb_xcc_id(); b.st = st;
    if (threadIdx.x == 0) (void)xb_add(&bar[XB_XCNT(b.x)], 1u);
    return b;
}
__device__ __forceinline__ void xcd_barrier_complete(unsigned* bar, unsigned x, unsigned& nloc, unsigned& nx) {
    const unsigned G = gridDim.x * gridDim.y * gridDim.z;
    unsigned sum, cnt, mine, sp = 0u;
    for (;;) {
        sum = 0u; cnt = 0u; mine = 0u;
#pragma unroll
        for (unsigned j = 0; j < 16; ++j) { const unsigned c = xb_ld(&bar[XB_XCNT(j)]); sum += c; cnt += (c > 0u) ? 1u : 0u; mine = (j == x) ? c : mine; }
        if (sum == G) break;
        __builtin_amdgcn_s_sleep(1);
        if ((++sp & 255u) == 0u) { if (xb_ld(&bar[XB_TMO])) break; if (sp > XB_SPIN_CAP) { atomicAdd(&bar[XB_TMO], 1u); break; } }
    }
    nloc = mine > 0u ? mine : 1u; nx = cnt > 0u ? cnt : 1u;
}

__device__ __forceinline__ void xcd_barrier(const XcdBarrier& b) {
    asm volatile("s_waitcnt vmcnt(0)" ::: "memory");
    __syncthreads();
    if (threadIdx.x == 0) {
        unsigned* bar = b.bar;
        __builtin_amdgcn_s_waitcnt(0);
        unsigned nloc = b.st[0], nx = b.st[1];
        if (nloc == 0u) { xcd_barrier_complete(bar, b.x, nloc, nx); b.st[0] = nloc; b.st[1] = nx; }
        const unsigned old = xb_add(&bar[XB_XSUB(b.x)], 1u);
        const unsigned gen = old / nloc;
        if (old + 1u == (gen + 1u) * nloc) {
            __builtin_amdgcn_fence(__ATOMIC_RELEASE, "agent");
            asm volatile("s_waitcnt vmcnt(0)" ::: "memory");
            const unsigned og = xb_add(&bar[XB_TOP], 1u);
            const unsigned tg = og / nx;
            if (og + 1u == (tg + 1u) * nx) xb_add(&bar[XB_TOPGEN], 1u);
            else XB_SPIN(xb_ld(&bar[XB_TOPGEN]) == tg, bar);
            __builtin_amdgcn_fence(__ATOMIC_ACQUIRE, "agent");
            xb_add(&bar[XB_XGEN(b.x)], 1u);
            asm volatile("s_waitcnt vmcnt(0)" ::: "memory");
        } else {
            XB_SPIN(xb_ld(&bar[XB_XGEN(b.x)]) == gen, bar);
            __builtin_amdgcn_fence(__ATOMIC_ACQUIRE, "agent");
            asm volatile("s_waitcnt vmcnt(0)" ::: "memory");
        }
    }
    __syncthreads();
}
constexpr int NB = 8, SEQ = 2048, DM = 1024, MTOK = NB * SEQ;
constexpr int PCOLS = 4608;
constexpr int A_COLS = 2560, B_COLS = 1856;
constexpr int NEXP = 32, ROWS_PAD = 73728;
constexpr float LOG2E = 1.4426950408889634f;
constexpr float QSCALE = 0.125f * LOG2E;
constexpr float LAM_INIT = 0.35550906759096926f;

constexpr size_t MiB = 1u << 20;
constexpr size_t WS_CTL = 0, CTL_ZERO_BYTES = 1 * MiB;
constexpr size_t WS_MODP = 2 * MiB, WS_MOD = 5 * MiB, WS_BIAS = 6 * MiB;
constexpr size_t WS_WAB = 8 * MiB, WS_WOUT = 17 * MiB, WS_WQKV = 19 * MiB, WS_WAO = 25 * MiB;
constexpr size_t WS_W1T = 32 * MiB, WS_W2T = 288 * MiB;
constexpr size_t WS_H = 416 * MiB, WS_P = 448 * MiB, WS_XA = 592 * MiB, WS_XB = 656 * MiB, WS_YMIX = 720 * MiB;
constexpr size_t WS_HS = 752 * MiB, WS_ACT = 896 * MiB, WS_EO = 1040 * MiB;
constexpr size_t WS_REC = 1184 * MiB, WS_RY = 1408 * MiB, WS_RG = 1472 * MiB, WS_RBON = 1504 * MiB, WS_HO = 1506 * MiB;
constexpr size_t WS_ROUTE = 1570 * MiB, WS_END = 1574 * MiB;
constexpr size_t RT_E = 0, RT_W = 256 * 1024, RT_RANK = 512 * 1024, RT_POS = 768 * 1024, RT_GATE = 1024 * 1024;
constexpr int CW_CNT = 64;
constexpr int CW_BAR = 4096;
constexpr int SCR_BYTES = 139264;
constexpr int LDSCTL_OFF = SCR_BYTES;
constexpr int LDS_BYTES = SCR_BYTES + 16384;

typedef float f32x16 __attribute__((ext_vector_type(16)));
typedef short s16x4 __attribute__((ext_vector_type(4)));
typedef unsigned u32x2 __attribute__((ext_vector_type(2)));

struct Ptrs {
    const float* in[33]; float* out; unsigned char* ws;
};

__device__ __forceinline__ float bf2f(unsigned short b) { return __uint_as_float((unsigned)b << 16); }
__device__ __forceinline__ float bflo(unsigned w) { return __uint_as_float(w << 16); }
__device__ __forceinline__ float bfhi(unsigned w) { return __uint_as_float(w & 0xffff0000u); }
__device__ __forceinline__ float wave_sum(float v) {
#pragma unroll
    for (int o = 1; o < 64; o <<= 1) v += __shfl_xor(v, o);
    return v;
}
template <int CTRL> __device__ __forceinline__ float dpp_f(float x) { return __int_as_float(__builtin_amdgcn_update_dpp(0, __float_as_int(x), CTRL, 0xF, 0xF, true)); }
__device__ __forceinline__ float sum8(float x) {
    x += dpp_f<0xB1>(x); x += dpp_f<0x4E>(x); x += dpp_f<0x141>(x); return x;
}
__device__ __forceinline__ float sigmoidf_(float x) { return __builtin_amdgcn_rcpf(1.0f + __builtin_amdgcn_exp2f(-LOG2E * x)); }
__device__ __forceinline__ float expf_(float x) { return __builtin_amdgcn_exp2f(LOG2E * x); }
__device__ __forceinline__ bf16x8 pack8(float a0, float a1, float a2, float a3, float a4, float a5, float a6, float a7) {
    v4u w; w.x = pg8::cvt_pk_bf16(a0, a1); w.y = pg8::cvt_pk_bf16(a2, a3); w.z = pg8::cvt_pk_bf16(a4, a5); w.w = pg8::cvt_pk_bf16(a6, a7);
    return __builtin_bit_cast(bf16x8, w);
}
__device__ __forceinline__ int crow(int r, int hi) { return (r & 3) + 8 * (r >> 2) + 4 * hi; }

__device__ __forceinline__ void tr_item(const float* __restrict__ W, int K, int N, bf16* __restrict__ WT, LAS float* scr, int kb, int nb, int lane) {
    const int k0 = kb * 64, n0 = nb * 64;
    const float* src = W + (size_t)(k0 + (lane >> 4)) * N + n0 + (lane & 15) * 4;
    f32x4 v[16];
#pragma unroll
    for (int i = 0; i < 16; ++i) v[i] = *(const f32x4*)(src + (size_t)(4 * i) * N);
#pragma unroll
    for (int i = 0; i < 16; ++i) { LAS float* d = scr + (4 * i + (lane >> 4)) * 65 + (lane & 15) * 4; d[0] = v[i].x; d[1] = v[i].y; d[2] = v[i].z; d[3] = v[i].w; }
    LDS_WAIT(); asm volatile("" ::: "memory");
    const int kc = lane & 7;
#pragma unroll
    for (int j = 0; j < 8; ++j) { const int n = j * 8 + (lane >> 3); const LAS float* s = scr + (8 * kc) * 65 + n;
        v4u o; o.x = pg8::cvt_pk_bf16(s[0], s[65]); o.y = pg8::cvt_pk_bf16(s[2 * 65], s[3 * 65]); o.z = pg8::cvt_pk_bf16(s[4 * 65], s[5 * 65]); o.w = pg8::cvt_pk_bf16(s[6 * 65], s[7 * 65]);
        *(v4u*)(WT + (size_t)(n0 + n) * K + k0 + 8 * kc) = o; }
    LDS_WAIT(); asm volatile("" ::: "memory");
}

__device__ __forceinline__ void p0_prologue(const Ptrs& P, LAS unsigned char* lds, int tid, int lane, int wave, int blk, int G) {
    unsigned char* ws = P.ws;
    LAS float* ldsf = (LAS float*)lds;
    for (int i = tid; i < NB * DM; i += 512) { const int b = i >> 10, k = i & 1023; const float c = P.in[1][i]; ldsf[k * 8 + b] = c * sigmoidf_(c); }
    __syncthreads();
    {
        float* modp = (float*)(ws + WS_MODP);
        const int gw = blk * 8 + wave, NGW = G * 8;
        for (int task = gw; task < 1536; task += NGW) {
            const int kc = task & 7, cg = (task >> 3) % 96, l = task / 768;
            const int n = cg * 64 + lane;
            const float* w = P.in[2] + ((size_t)l * 1024 + kc * 128) * 6144 + n;
            float acc[8];
#pragma unroll
            for (int b = 0; b < 8; ++b) acc[b] = 0.f;
#pragma unroll 8
            for (int k = 0; k < 128; ++k) {
                const float wv = w[(size_t)k * 6144];
                const f32x4 c0 = *(const LAS f32x4*)(ldsf + (kc * 128 + k) * 8), c1 = *(const LAS f32x4*)(ldsf + (kc * 128 + k) * 8 + 4);
                acc[0] += c0.x * wv; acc[1] += c0.y * wv; acc[2] += c0.z * wv; acc[3] += c0.w * wv;
                acc[4] += c1.x * wv; acc[5] += c1.y * wv; acc[6] += c1.z * wv; acc[7] += c1.w * wv;
            }
#pragma unroll
            for (int b = 0; b < 8; ++b) modp[((size_t)(kc * 2 + l) * 8 + b) * 6144 + n] = acc[b];
        }
    }
    {
        float* biasT = (float*)(ws + WS_BIAS);
        for (int idx = blk * 512 + tid; idx < 8 * 4096; idx += G * 512) {
            const int h = idx >> 12, i = idx & 4095;
            if (i < 4095) {
                const int rel = i - 2047, n = rel < 0 ? -rel : rel;
                int bk = n < 8 ? n : n < 12 ? 8 : n < 16 ? 9 : n < 23 ? 10 : n < 32 ? 11 : n < 46 ? 12 : n < 64 ? 13 : n < 91 ? 14 : 15;
                if (rel > 0) bk += 16;
                biasT[idx] = P.in[31][bk * 8 + h] * LOG2E;
            }
        }
    }
    {
        v4u* z = (v4u*)(ws + WS_WAB + (size_t)4416 * 1024 * 2);
        for (int i = blk * 512 + tid; i < 192 * 1024 * 2 / 16; i += G * 512) z[i] = (v4u){0u, 0u, 0u, 0u};
    }
    __syncthreads();
    {
        LAS float* scr = (LAS float*)(lds + wave * 16640);
        const int gw = blk * 8 + wave, NGW = G * 8;
        constexpr int I0 = 16 * 69, I1 = 256, I2 = 16 * 48, I3 = 256, I4 = 64 * 512, I5 = 64 * 256;
        for (int it = gw; it < I0 + I1 + I2 + I3 + I4 + I5; it += NGW) {
            int r = it;
            if (r < I0) { tr_item(P.in[12], 1024, 4416, (bf16*)(ws + WS_WAB), scr, r / 69, r % 69, lane); continue; } r -= I0;
            if (r < I1) { tr_item(P.in[13], 1024, 1024, (bf16*)(ws + WS_WOUT), scr, r >> 4, r & 15, lane); continue; } r -= I1;
            if (r < I2) { tr_item(P.in[27], 1024, 3072, (bf16*)(ws + WS_WQKV), scr, r / 48, r % 48, lane); continue; } r -= I2;
            if (r < I3) { tr_item(P.in[28], 1024, 1024, (bf16*)(ws + WS_WAO), scr, r >> 4, r & 15, lane); continue; } r -= I3;
            if (r < I4) { const int mat = r >> 9, q = r & 511; tr_item(P.in[8] + (size_t)mat * 1024 * 2048, 1024, 2048, (bf16*)(ws + WS_W1T) + (size_t)mat * 2048 * 1024, scr, q >> 5, q & 31, lane); continue; } r -= I4;
            { const int mat = r >> 8, q = r & 255; tr_item(P.in[10] + (size_t)mat * 1024 * 1024, 1024, 1024, (bf16*)(ws + WS_W2T) + (size_t)mat * 1024 * 1024, scr, q >> 4, q & 15, lane); }
        }
    }
}

template <bool FROM_PART>
__device__ __forceinline__ void load_mod_vec(const Ptrs& P, LAS float* eg, LAS float* sh, const float* gain, int l, int b, int which_shift, int tid) {
    const float* modp = (const float*)(P.ws + WS_MODP); const float* mod = (const float*)(P.ws + WS_MOD);
    for (int k = tid; k < 1024; k += 512) {
        float s, c;
        if (FROM_PART) {
            s = P.in[3][l * 6144 + which_shift * 1024 + k]; c = P.in[3][l * 6144 + (which_shift + 1) * 1024 + k];
#pragma unroll
            for (int kc = 0; kc < 8; ++kc) { s += modp[((size_t)(kc * 2 + l) * 8 + b) * 6144 + which_shift * 1024 + k]; c += modp[((size_t)(kc * 2 + l) * 8 + b) * 6144 + (which_shift + 1) * 1024 + k]; }
        } else { s = mod[((size_t)l * 8 + b) * 6144 + which_shift * 1024 + k]; c = mod[((size_t)l * 8 + b) * 6144 + (which_shift + 1) * 1024 + k]; }
        eg[k] = gain[k] * (1.0f + c); sh[k] = s;
    }
}
__device__ __forceinline__ float row_rstd(const f32x4 (&v)[4]) {
    float s = 0.f;
#pragma unroll
    for (int j = 0; j < 4; ++j) s += (v[j].x * v[j].x + v[j].y * v[j].y) + (v[j].z * v[j].z + v[j].w * v[j].w);
    return 1.0f / sqrtf(wave_sum(s) * (1.0f / 1024.0f) + 1e-6f);
}
__device__ __forceinline__ void store_h_row(bf16* hrow, const f32x4 (&v)[4], float rstd, const LAS float* eg, const LAS float* sh, int lane) {
#pragma unroll
    for (int j = 0; j < 4; ++j) { const int k = 4 * lane + 256 * j; const f32x4 g = *(const LAS f32x4*)(eg + k), s = *(const LAS f32x4*)(sh + k);
        u32x2 w; w.x = pg8::cvt_pk_bf16(v[j].x * rstd * g.x + s.x, v[j].y * rstd * g.y + s.y); w.y = pg8::cvt_pk_bf16(v[j].z * rstd * g.z + s.z, v[j].w * rstd * g.w + s.w);
        *(u32x2*)(hrow + k) = w; }
}
__device__ __forceinline__ void p1_norm0(const Ptrs& P, LAS unsigned char* lds, int tid, int lane, int wave, int blk, int G) {
    LAS float* eg = (LAS float*)lds; LAS float* sh = eg + 1024;
    {
        const float* modp = (const float*)(P.ws + WS_MODP); float* mod = (float*)(P.ws + WS_MOD);
        for (int i = blk * 512 + tid; i < 2 * 8 * 6144; i += G * 512) { const int n = i % 6144, lb = i / 6144, l = lb >> 3, b = lb & 7; float s = P.in[3][l * 6144 + n];
#pragma unroll
            for (int kc = 0; kc < 8; ++kc) s += modp[((size_t)(kc * 2 + l) * 8 + b) * 6144 + n];
            mod[i] = s; }
    }
    bf16* H = (bf16*)(P.ws + WS_H);
    for (int rb = blk; rb < 256; rb += G) {
        const int b = rb >> 5;
        __syncthreads();
        load_mod_vec<true>(P, eg, sh, P.in[4], 0, b, 0, tid);
        __syncthreads();
        for (int i = 0; i < 8; ++i) { const int m = rb * 64 + wave * 8 + i; const f32x4* xr = (const f32x4*)(P.in[0] + (size_t)m * 1024) + lane;
            f32x4 v[4];
#pragma unroll
            for (int j = 0; j < 4; ++j) v[j] = xr[64 * j];
            const float rstd = row_rstd(v); store_h_row(H + (size_t)m * 1024, v, rstd, eg, sh, lane); }
    }
}
__device__ __forceinline__ void p3_rwkv_prep(const Ptrs& P, LAS unsigned char* lds, int tid, int lane, int wave, int blk, int G) {
    LAS float* Rl = (LAS float*)lds;
    LAS float* Kl = Rl + 8 * 512;
    LAS float* Vl = Kl + 8 * 512;
    LAS float* LWF = Vl + 8 * 512;
    LAS float* LWB = LWF + 64 * 8;
    LAS float* LA = LWB + 64 * 8;
    LAS float* LG = LA + 64 * 8;
    const bf16* Pb = (const bf16*)(P.ws + WS_P);
    float* REC = (float*)(P.ws + WS_REC); float* RG = (float*)(P.ws + WS_RG); float* RBON = (float*)(P.ws + WS_RBON);
    const float* mu = P.in[16]; const float* w0 = P.in[17]; const float* w2 = P.in[18]; const float* a0 = P.in[19]; const float* a2 = P.in[20]; const float* g2 = P.in[21];
    const float* k_k = P.in[22]; const float* k_a = P.in[23]; const float* r_k = P.in[24];
    const int c = tid, h = wave;
    const float w0f = w0[c], w0b = w0[512 + c], a0c = a0[c], kkc = k_k[c], kac = k_a[c], rkc = r_k[c];
    for (int tile = blk; tile < MTOK / 8; tile += G) {
        const int m0 = tile * 8, t0 = m0 & 2047, b = m0 >> 11;
        __syncthreads();
        for (int cp = tid; cp < B_COLS / 2; cp += 512) {
            const int col = 2 * cp;
            const unsigned* src = (const unsigned*)(Pb + (size_t)m0 * PCOLS + A_COLS + col);
            unsigned w[10];
#pragma unroll
            for (int j = 0; j < 10; ++j) { const int t = t0 - 1 + j; w[j] = (t >= 0 && t < 2048) ? src[(ptrdiff_t)(j - 1) * (PCOLS / 2)] : 0u; }
            const float mu0 = mu[col], mu1 = mu[col + 1];
#pragma unroll
            for (int j = 0; j < 8; ++j) {
                const float p0 = bflo(w[j + 1]), p1 = bfhi(w[j + 1]);
                const float v0 = p0 + mu0 * (0.5f * (bflo(w[j]) + bflo(w[j + 2])) - p0), v1 = p1 + mu1 * (0.5f * (bfhi(w[j]) + bfhi(w[j + 2])) - p1);
                if (col < 512) { Rl[j * 512 + col] = v0; Rl[j * 512 + col + 1] = v1; }
                else if (col < 1024) { Kl[j * 512 + col - 512] = v0; Kl[j * 512 + col - 511] = v1; }
                else if (col < 1536) { Vl[j * 512 + col - 1024] = v0; Vl[j * 512 + col - 1023] = v1; }
                else if (col < 1600) { LWF[(col - 1536) * 8 + j] = tanhf(v0); LWF[(col - 1535) * 8 + j] = tanhf(v1); }
                else if (col < 1664) { LWB[(col - 1600) * 8 + j] = tanhf(v0); LWB[(col - 1599) * 8 + j] = tanhf(v1); }
                else if (col < 1728) { LA[(col - 1664) * 8 + j] = v0; LA[(col - 1663) * 8 + j] = v1; }
                else { LG[(col - 1728) * 8 + j] = sigmoidf_(v0); LG[(col - 1727) * 8 + j] = sigmoidf_(v1); }
            }
        }
        __syncthreads();
        float awf[8], awb[8], aa[8], ag[8];
#pragma unroll
        for (int j = 0; j < 8; ++j) { awf[j] = 0.f; awb[j] = 0.f; aa[j] = 0.f; ag[j] = 0.f; }
#pragma unroll 4
        for (int l = 0; l < 64; ++l) {
            const float wf = w2[l * 512 + c], wb = w2[(64 + l) * 512 + c], wa = a2[l * 512 + c];
            const f32x4 f0 = *(const LAS f32x4*)(LWF + l * 8), f1 = *(const LAS f32x4*)(LWF + l * 8 + 4);
            const f32x4 b0 = *(const LAS f32x4*)(LWB + l * 8), b1 = *(const LAS f32x4*)(LWB + l * 8 + 4);
            const f32x4 x0 = *(const LAS f32x4*)(LA + l * 8), x1 = *(const LAS f32x4*)(LA + l * 8 + 4);
#pragma unroll
            for (int j = 0; j < 4; ++j) { awf[j] += f0[j] * wf; awf[j + 4] += f1[j] * wf; awb[j] += b0[j] * wb; awb[j + 4] += b1[j] * wb; aa[j] += x0[j] * wa; aa[j + 4] += x1[j] * wa; }
        }
#pragma unroll 4
        for (int l = 0; l < 128; ++l) {
            const float wg = g2[l * 512 + c];
            const f32x4 g0 = *(const LAS f32x4*)(LG + l * 8), g1 = *(const LAS f32x4*)(LG + l * 8 + 4);
#pragma unroll
            for (int j = 0; j < 4; ++j) { ag[j] += g0[j] * wg; ag[j + 4] += g1[j] * wg; }
        }
#pragma unroll
        for (int j = 0; j < 8; ++j) {
            const int m = m0 + j, t = t0 + j;
            float zf = -(w0f + awf[j]), zb = -(w0b + awb[j]);
            const float spf = fmaxf(zf, 0.f) + log1pf(expf_(-fabsf(zf))), spb = fmaxf(zb, 0.f) + log1pf(expf_(-fabsf(zb)));
            const float df = expf_(-expf_(-spf - 0.5f)), db = expf_(-expf_(-spb - 0.5f));
            const float a = sigmoidf_(a0c + aa[j]);
            const float kraw = Kl[j * 512 + c], rr = Rl[j * 512 + c], vv = Vl[j * 512 + c];
            const float kkr = kraw * kkc;
            const float ss = wave_sum(kkr * kkr);
            const float kk = kkr / fmaxf(sqrtf(ss), 1e-12f);
            const float kp = kraw * (1.0f + (a - 1.0f) * kac);
            const float bon = wave_sum(rr * kp * rkc);
            float* rec = REC + ((size_t)(b * 8 + h) * 2048 + t) * 448 + lane;
            rec[0] = df; rec[64] = db; rec[128] = kp; rec[192] = kk; rec[256] = kk * a; rec[320] = rr; rec[384] = vv;
            RG[(size_t)m * 512 + c] = ag[j];
            if (lane == 0) RBON[(size_t)m * 8 + h] = bon;
        }
    }
}

__device__ __forceinline__ void rwkv_scan_unit(const Ptrs& P, LAS unsigned char* lds, int unit, int tid, int lane, int wave) {
    const int dir = unit >> 6, bh = unit & 63;
    LAS float* buf = (LAS float*)lds;
    LAS float* ybuf = buf + 2 * 16 * 384;
    const float* REC = (const float*)(P.ws + WS_REC) + (size_t)bh * 2048 * 448;
    float* Y = (float*)(P.ws + WS_RY) + (size_t)dir * MTOK * 512;
    const int kg = lane & 7, row = wave * 8 + (lane >> 3);
    const int b = bh >> 3, h = bh & 7;
    float S[8];
#pragma unroll
    for (int i = 0; i < 8; ++i) S[i] = 0.f;
    f32x4 pre[3];
    auto issue = [&](int chunk) {
#pragma unroll
        for (int i = 0; i < 3; ++i) { const int idx = tid + 512 * i; const int s = idx / 96, rem = idx - s * 96, j = rem >> 4, q4 = rem & 15;
            const int step = chunk * 16 + s; const int t = dir ? 2047 - step : step; const int sv = (j == 0) ? dir : j + 1;
            pre[i] = *(const f32x4*)(REC + (size_t)t * 448 + sv * 64 + q4 * 4); }
    };
    auto commit = [&](int chunk) {
#pragma unroll
        for (int i = 0; i < 3; ++i) { const int idx = tid + 512 * i; const int s = idx / 96, rem = idx - s * 96;
            *(LAS f32x4*)(buf + (chunk & 1) * (16 * 384) + s * 384 + rem * 4) = pre[i]; }
    };
    __syncthreads();
    issue(0); commit(0);
    __syncthreads();
    for (int chunk = 0; chunk < 128; ++chunk) {
        if (chunk + 1 < 128) issue(chunk + 1);
        const LAS float* cb = buf + (chunk & 1) * (16 * 384);
        LAS float* yb = ybuf + (chunk & 1) * (16 * 64);
#pragma unroll 4
        for (int s = 0; s < 16; ++s) {
            const LAS float* st = cb + s * 384 + kg * 8;
            const f32x4 w0 = *(const LAS f32x4*)(st), w1 = *(const LAS f32x4*)(st + 4);
            const f32x4 kp0 = *(const LAS f32x4*)(st + 64), kp1 = *(const LAS f32x4*)(st + 68);
            const f32x4 kk0 = *(const LAS f32x4*)(st + 128), kk1 = *(const LAS f32x4*)(st + 132);
            const f32x4 bv0 = *(const LAS f32x4*)(st + 192), bv1 = *(const LAS f32x4*)(st + 196);
            const f32x4 r0 = *(const LAS f32x4*)(st + 256), r1 = *(const LAS f32x4*)(st + 260);
            const float vt = cb[s * 384 + 320 + row];
            float sa0 = S[0] * kk0.x + S[1] * kk0.y, sa1 = S[2] * kk0.z + S[3] * kk0.w;
            sa0 += S[4] * kk1.x + S[5] * kk1.y; sa1 += S[6] * kk1.z + S[7] * kk1.w;
            const float sa = -sum8(sa0 + sa1);
            S[0] = S[0] * w0.x + (sa * bv0.x + vt * kp0.x); S[1] = S[1] * w0.y + (sa * bv0.y + vt * kp0.y);
            S[2] = S[2] * w0.z + (sa * bv0.z + vt * kp0.z); S[3] = S[3] * w0.w + (sa * bv0.w + vt * kp0.w);
            S[4] = S[4] * w1.x + (sa * bv1.x + vt * kp1.x); S[5] = S[5] * w1.y + (sa * bv1.y + vt * kp1.y);
            S[6] = S[6] * w1.z + (sa * bv1.z + vt * kp1.z); S[7] = S[7] * w1.w + (sa * bv1.w + vt * kp1.w);
            float y0 = S[0] * r0.x + S[1] * r0.y, y1 = S[2] * r0.z + S[3] * r0.w;
            y0 += S[4] * r1.x + S[5] * r1.y; y1 += S[6] * r1.z + S[7] * r1.w;
            const float y = sum8(y0 + y1);
            if (kg == 0) yb[s * 64 + row] = y;
        }
        if (chunk + 1 < 128) commit(chunk + 1);
        __syncthreads();
        if (tid < 256) { const int s = tid >> 4, q4 = tid & 15; const int step = chunk * 16 + s; const int t = dir ? 2047 - step : step;
            *(f32x4*)(Y + (size_t)(b * 2048 + t) * 512 + h * 64 + q4 * 4) = *(const LAS f32x4*)(yb + s * 64 + q4 * 4); }
    }
    __syncthreads();
}
constexpr int HG_QP = 136, HG_TP = 40;
__device__ __forceinline__ void hgrn_unit(const Ptrs& P, LAS unsigned char* lds, int unit, int tid, int lane, int wave) {
    const int dir = unit & 1, bh = unit >> 1, b = bh >> 2, h = bh & 3;
    LAS bf16* Qin = (LAS bf16*)lds;
    LAS bf16* Kin = Qin + 32 * HG_QP;
    LAS bf16* Qdec = Kin + 32 * HG_QP;
    LAS bf16* KstT = Qdec + 32 * HG_QP;
    LAS bf16* VT = KstT + 128 * HG_TP;
    LAS float* seg = (LAS float*)(VT + 128 * HG_TP);
    LAS float* dec = seg + 4 * 128;
    const bf16* Pb = (const bf16*)(P.ws + WS_P);
    float* HO = (float*)(P.ws + WS_HO) + (size_t)dir * MTOK * 512;
    const int ch = tid & 127, jq = tid >> 7;
    float lbv;
    { const float l0 = P.in[14][dir * 1024 + h * 128 + ch], l1 = P.in[14][dir * 1024 + 512 + h * 128 + ch]; lbv = 1.0f / (1.0f + expf_(l1 - l0)); }
    const int r32 = lane & 31, hi = lane >> 5;
    f32x16 Sacc[4];
#pragma unroll
    for (int i = 0; i < 4; ++i)
#pragma unroll
        for (int r = 0; r < 16; ++r) Sacc[i][r] = 0.f;
    const size_t rowb = (size_t)b * 2048;
    for (int c = 0; c < 64; ++c) {
        float lf[8], qv[8], kv[8], vv[8];
#pragma unroll
        for (int i = 0; i < 8; ++i) {
            const int j = 8 * jq + i; const int t = dir ? 2047 - (32 * c + j) : 32 * c + j;
            const bf16* pr = Pb + (rowb + t) * PCOLS + h * 128 + ch;
            const float q = bf2f(pr[0]), f = bf2f(pr[512 + dir * 512]), iv = bf2f(pr[1536]);
            const float fg = lbv + (1.0f - lbv) * sigmoidf_(f);
            lf[i] = __logf(fg); qv[i] = q * sigmoidf_(q); kv[i] = 1.0f - fg; vv[i] = iv;
        }
#pragma unroll
        for (int i = 1; i < 8; ++i) lf[i] += lf[i - 1];
        __syncthreads();
        seg[jq * 128 + ch] = lf[7];
        __syncthreads();
        const float s0 = seg[ch], s1 = seg[128 + ch], s2 = seg[256 + ch], s3 = seg[384 + ch];
        const float off = jq == 0 ? 0.f : jq == 1 ? s0 : jq == 2 ? s0 + s1 : s0 + s1 + s2;
        const float bref = s0 + s1, blast = (s0 + s1) + (s2 + s3);
        float kst[8];
#pragma unroll
        for (int i = 0; i < 8; ++i) { const int j = 8 * jq + i; const float bj = off + lf[i];
            Qin[j * HG_QP + ch] = (bf16)(pg8::cvt_pk_bf16(qv[i] * expf_(bj - bref), 0.f) & 0xffffu);
            Kin[j * HG_QP + ch] = (bf16)(pg8::cvt_pk_bf16(kv[i] * expf_(bref - bj), 0.f) & 0xffffu);
            Qdec[j * HG_QP + ch] = (bf16)(pg8::cvt_pk_bf16(qv[i] * expf_(bj), 0.f) & 0xffffu);
            kst[i] = kv[i] * expf_(blast - bj); }
        *(LAS bf16x8*)(KstT + ch * HG_TP + 8 * jq) = pack8(kst[0], kst[1], kst[2], kst[3], kst[4], kst[5], kst[6], kst[7]);
        *(LAS bf16x8*)(VT + ch * HG_TP + 8 * jq) = pack8(vv[0], vv[1], vv[2], vv[3], vv[4], vv[5], vv[6], vv[7]);
        if (jq == 0) dec[ch] = expf_(blast);
        __syncthreads();
        if (wave < 4) {
            const int dvb = wave;
            f32x16 X;
#pragma unroll
            for (int r = 0; r < 16; ++r) X[r] = 0.f;
#pragma unroll
            for (int ks = 0; ks < 8; ++ks) {
                const bf16x8 a = *(const LAS bf16x8*)(Kin + r32 * HG_QP + 16 * ks + 8 * hi);
                const bf16x8 bq = *(const LAS bf16x8*)(Qin + r32 * HG_QP + 16 * ks + 8 * hi);
                X = __builtin_amdgcn_mfma_f32_32x32x16_bf16(a, bq, X, 0, 0, 0);
            }
#pragma unroll
            for (int r = 0; r < 16; ++r) if (crow(r, hi) > r32) X[r] = 0.f;
            const bf16x8 pa0 = pack8(X[0], X[1], X[2], X[3], X[4], X[5], X[6], X[7]);
            const bf16x8 pa1 = pack8(X[8], X[9], X[10], X[11], X[12], X[13], X[14], X[15]);
            f32x16 o;
#pragma unroll
            for (int r = 0; r < 16; ++r) o[r] = 0.f;
            {
                const LAS bf16* vp = VT + (32 * dvb + r32) * HG_TP + 4 * hi;
                const s16x4 b00 = *(const LAS s16x4*)(vp), b01 = *(const LAS s16x4*)(vp + 8), b10 = *(const LAS s16x4*)(vp + 16), b11 = *(const LAS s16x4*)(vp + 24);
                const bf16x8 vb0 = (bf16x8){b00[0], b00[1], b00[2], b00[3], b01[0], b01[1], b01[2], b01[3]};
                const bf16x8 vb1 = (bf16x8){b10[0], b10[1], b10[2], b10[3], b11[0], b11[1], b11[2], b11[3]};
                o = __builtin_amdgcn_mfma_f32_32x32x16_bf16(pa0, vb0, o, 0, 0, 0);
                o = __builtin_amdgcn_mfma_f32_32x32x16_bf16(pa1, vb1, o, 0, 0, 0);
            }
#pragma unroll
            for (int dkt = 0; dkt < 4; ++dkt) {
#pragma unroll
                for (int s2 = 0; s2 < 2; ++s2) {
                    const LAS bf16* qp = Qdec + r32 * HG_QP + 32 * dkt + 16 * s2 + 4 * hi;
                    const s16x4 a0 = *(const LAS s16x4*)(qp), a1 = *(const LAS s16x4*)(qp + 8);
                    const bf16x8 af = (bf16x8){a0[0], a0[1], a0[2], a0[3], a1[0], a1[1], a1[2], a1[3]};
                    const bf16x8 sb = pack8(Sacc[dkt][8 * s2 + 0], Sacc[dkt][8 * s2 + 1], Sacc[dkt][8 * s2 + 2], Sacc[dkt][8 * s2 + 3], Sacc[dkt][8 * s2 + 4], Sacc[dkt][8 * s2 + 5], Sacc[dkt][8 * s2 + 6], Sacc[dkt][8 * s2 + 7]);
                    o = __builtin_amdgcn_mfma_f32_32x32x16_bf16(af, sb, o, 0, 0, 0);
                }
            }
#pragma unroll
            for (int r = 0; r < 16; ++r) { const int j = crow(r, hi); const int t = dir ? 2047 - (32 * c + j) : 32 * c + j;
                HO[(rowb + t) * 512 + h * 128 + 32 * dvb + r32] = o[r]; }
#pragma unroll
            for (int dkt = 0; dkt < 4; ++dkt) {
#pragma unroll
                for (int g = 0; g < 4; ++g) { const f32x4 d4 = *(const LAS f32x4*)(dec + 32 * dkt + 8 * g + 4 * hi);
                    Sacc[dkt][4 * g + 0] *= d4.x; Sacc[dkt][4 * g + 1] *= d4.y; Sacc[dkt][4 * g + 2] *= d4.z; Sacc[dkt][4 * g + 3] *= d4.w; }
#pragma unroll
                for (int ks = 0; ks < 2; ++ks) {
                    const bf16x8 a = *(const LAS bf16x8*)(KstT + (32 * dkt + r32) * HG_TP + 16 * ks + 8 * hi);
                    const bf16x8 bv = *(const LAS bf16x8*)(VT + (32 * dvb + r32) * HG_TP + 16 * ks + 8 * hi);
                    Sacc[dkt] = __builtin_amdgcn_mfma_f32_32x32x16_bf16(a, bv, Sacc[dkt], 0, 0, 0);
                }
            }
        }
    }
    __syncthreads();
}

__device__ __forceinline__ void p5_combine(const Ptrs& P, int lane, int wave, int blk, int G) {
    const float* HOf = (const float*)(P.ws + WS_HO); const float* HOb = HOf + (size_t)MTOK * 512;
    const float* Yf = (const float*)(P.ws + WS_RY); const float* Yb = Yf + (size_t)MTOK * 512;
    const float* RG = (const float*)(P.ws + WS_RG); const float* RBON = (const float*)(P.ws + WS_RBON); const float* REC = (const float*)(P.ws + WS_REC);
    const bf16* Pb = (const bf16*)(P.ws + WS_P); bf16* YM = (bf16*)(P.ws + WS_YMIX);
    const float* hng = P.in[15]; const float* lng = P.in[25]; const float* lnb = P.in[26];
    for (int m = blk * 8 + wave; m < MTOK; m += G * 8) {
        {
            const int c0 = lane * 8;
            const f32x4 a0 = *(const f32x4*)(HOf + (size_t)m * 512 + c0), a1 = *(const f32x4*)(HOf + (size_t)m * 512 + c0 + 4);
            const f32x4 b0 = *(const f32x4*)(HOb + (size_t)m * 512 + c0), b1 = *(const f32x4*)(HOb + (size_t)m * 512 + c0 + 4);
            float o[8] = {a0.x + b0.x, a0.y + b0.y, a0.z + b0.z, a0.w + b0.w, a1.x + b1.x, a1.y + b1.y, a1.z + b1.z, a1.w + b1.w};
            float ss = 0.f;
#pragma unroll
            for (int i = 0; i < 8; ++i) ss += o[i] * o[i];
            ss += __shfl_xor(ss, 1); ss += __shfl_xor(ss, 2); ss += __shfl_xor(ss, 4); ss += __shfl_xor(ss, 8);
            const float rstd = 1.0f / sqrtf(ss * (1.0f / 128.0f) + 1e-6f);
            const v4u gw = *(const v4u*)(Pb + (size_t)m * PCOLS + 2048 + c0);
            const float g[8] = {bflo(gw.x), bfhi(gw.x), bflo(gw.y), bfhi(gw.y), bflo(gw.z), bfhi(gw.z), bflo(gw.w), bfhi(gw.w)};
            const int cn = (lane & 15) * 8;
            float y[8];
#pragma unroll
            for (int i = 0; i < 8; ++i) y[i] = o[i] * rstd * hng[cn + i] * (g[i] * sigmoidf_(g[i]));
            *(bf16x8*)(YM + (size_t)m * 1024 + c0) = pack8(y[0], y[1], y[2], y[3], y[4], y[5], y[6], y[7]);
        }
        {
            const int c0 = lane * 8, hh = lane >> 3;
            const f32x4 a0 = *(const f32x4*)(Yf + (size_t)m * 512 + c0), a1 = *(const f32x4*)(Yf + (size_t)m * 512 + c0 + 4);
            const f32x4 b0 = *(const f32x4*)(Yb + (size_t)m * 512 + c0), b1 = *(const f32x4*)(Yb + (size_t)m * 512 + c0 + 4);
            float y[8] = {a0.x + b0.x, a0.y + b0.y, a0.z + b0.z, a0.w + b0.w, a1.x + b1.x, a1.y + b1.y, a1.z + b1.z, a1.w + b1.w};
            float s = 0.f;
#pragma unroll
            for (int i = 0; i < 8; ++i) s += y[i];
            s += __shfl_xor(s, 1); s += __shfl_xor(s, 2); s += __shfl_xor(s, 4);
            const float mean = s * (1.0f / 64.0f);
            float q = 0.f;
#pragma unroll
            for (int i = 0; i < 8; ++i) { y[i] -= mean; q += y[i] * y[i]; }
            q += __shfl_xor(q, 1); q += __shfl_xor(q, 2); q += __shfl_xor(q, 4);
            const float rstd = 1.0f / sqrtf(q * (1.0f / 64.0f) + 64e-5f);
            const float bon = RBON[(size_t)m * 8 + hh];
            const int b = m >> 11, t = m & 2047;
            const float* vr = REC + ((size_t)(b * 8 + hh) * 2048 + t) * 448 + 384 + (lane & 7) * 8;
            const f32x4 v0 = *(const f32x4*)vr, v1 = *(const f32x4*)(vr + 4);
            const f32x4 g0 = *(const f32x4*)(RG + (size_t)m * 512 + c0), g1 = *(const f32x4*)(RG + (size_t)m * 512 + c0 + 4);
            const float vv[8] = {v0.x, v0.y, v0.z, v0.w, v1.x, v1.y, v1.z, v1.w}, gg[8] = {g0.x, g0.y, g0.z, g0.w, g1.x, g1.y, g1.z, g1.w};
            float z[8];
#pragma unroll
            for (int i = 0; i < 8; ++i) z[i] = (y[i] * rstd * lng[c0 + i] + lnb[c0 + i] + bon * vv[i]) * gg[i];
            *(bf16x8*)(YM + (size_t)m * 1024 + 512 + c0) = pack8(z[0], z[1], z[2], z[3], z[4], z[5], z[6], z[7]);
        }
    }
}
constexpr int LC_TILE = 0, LC_SEG = 2048, LC_HIST = 2304, LC_BASE = 2432, LC_TOTAL = 2560, LC_LOG = 2816, LC_PE = 6912, LC_PW = 7936, LC_PLR = 8960, LC_MISC = 12288;

__device__ __forceinline__ void p7_router(const Ptrs& P, LAS unsigned char* lds, int layer, const float* xin, int tid, int lane, int wave, int blk, int G) {
    LAS float* eg = (LAS float*)lds; LAS float* sh = eg + 1024;
    LAS float* rowbuf = (LAS float*)(lds + 8192) + wave * 4096;
    LAS unsigned char* lc = lds + LDSCTL_OFF;
    LAS int* hist = (LAS int*)(lc + LC_HIST); LAS int* base = (LAS int*)(lc + LC_BASE);
    LAS float* lg = (LAS float*)(lc + LC_LOG) + wave * 128;
    LAS int* pe = (LAS int*)(lc + LC_PE); LAS float* pw = (LAS float*)(lc + LC_PW); LAS int* plr = (LAS int*)(lc + LC_PLR);
    bf16* H = (bf16*)(P.ws + WS_H);
    const float* Wr = P.in[6] + (size_t)layer * 1024 * 32; const float* rb_ = P.in[7] + layer * 32;
    unsigned* cnt = (unsigned*)(P.ws + WS_CTL) + CW_CNT + layer * 64;
    int* TE = (int*)(P.ws + WS_ROUTE + RT_E); float* TW = (float*)(P.ws + WS_ROUTE + RT_W); int* TR = (int*)(P.ws + WS_ROUTE + RT_RANK);
    for (int rb = blk; rb < 256; rb += G) {
        const int b = rb >> 5;
        __syncthreads();
        load_mod_vec<false>(P, eg, sh, P.in[5] + layer * 1024, layer, b, 3, tid);
        if (tid < 32) hist[tid] = 0;
        __syncthreads();
        for (int pass = 0; pass < 2; ++pass) {
#pragma unroll 1
            for (int i = 0; i < 4; ++i) { const int m = rb * 64 + wave * 8 + pass * 4 + i; const f32x4* xr = (const f32x4*)(xin + (size_t)m * 1024) + lane;
                f32x4 v[4];
#pragma unroll
                for (int j = 0; j < 4; ++j) v[j] = xr[64 * j];
                const float rstd = row_rstd(v);
                store_h_row(H + (size_t)m * 1024, v, rstd, eg, sh, lane);
#pragma unroll
                for (int j = 0; j < 4; ++j) { const int k = 4 * lane + 256 * j; const f32x4 g = *(const LAS f32x4*)(eg + k), s = *(const LAS f32x4*)(sh + k);
                    f32x4 o; o.x = v[j].x * rstd * g.x + s.x; o.y = v[j].y * rstd * g.y + s.y; o.z = v[j].z * rstd * g.z + s.z; o.w = v[j].w * rstd * g.w + s.w;
                    *(LAS f32x4*)(rowbuf + i * 1024 + k) = o; } }
            LDS_WAIT(); asm volatile("" ::: "memory");
            const int e = lane & 31, kh = lane >> 5;
            float a0 = 0.f, a1 = 0.f, a2 = 0.f, a3 = 0.f;
            const float* wp = Wr + (size_t)(512 * kh) * 32 + e; const LAS float* rp = rowbuf + 512 * kh;
#pragma unroll 2
            for (int k = 0; k < 512; k += 4) {
                const float w0 = wp[(k + 0) * 32], w1 = wp[(k + 1) * 32], w2 = wp[(k + 2) * 32], w3 = wp[(k + 3) * 32];
                const f32x4 r0 = *(const LAS f32x4*)(rp + k), r1 = *(const LAS f32x4*)(rp + 1024 + k), r2 = *(const LAS f32x4*)(rp + 2048 + k), r3 = *(const LAS f32x4*)(rp + 3072 + k);
                a0 += r0.x * w0 + r0.y * w1 + r0.z * w2 + r0.w * w3; a1 += r1.x * w0 + r1.y * w1 + r1.z * w2 + r1.w * w3;
                a2 += r2.x * w0 + r2.y * w1 + r2.z * w2 + r2.w * w3; a3 += r3.x * w0 + r3.y * w1 + r3.z * w2 + r3.w * w3;
            }
            a0 += __shfl_xor(a0, 32); a1 += __shfl_xor(a1, 32); a2 += __shfl_xor(a2, 32); a3 += __shfl_xor(a3, 32);
            if (lane < 32) { const float bb = rb_[e]; lg[e] = a0 + bb; lg[32 + e] = a1 + bb; lg[64 + e] = a2 + bb; lg[96 + e] = a3 + bb; }
            LDS_WAIT(); asm volatile("" ::: "memory");
            if (lane < 4) {
                const LAS float* lr = lg + lane * 32;
                float v0 = -3e38f, v1 = -3e38f, v2 = -3e38f, v3 = -3e38f; int i0 = 0, i1 = 0, i2 = 0, i3 = 0;
                for (int q = 0; q < 32; ++q) { const float x = lr[q];
                    if (x > v0) { v3 = v2; i3 = i2; v2 = v1; i2 = i1; v1 = v0; i1 = i0; v0 = x; i0 = q; }
                    else if (x > v1) { v3 = v2; i3 = i2; v2 = v1; i2 = i1; v1 = x; i1 = q; }
                    else if (x > v2) { v3 = v2; i3 = i2; v2 = x; i2 = q; }
                    else if (x > v3) { v3 = x; i3 = q; } }
                const float e1 = expf_(v1 - v0), e2 = expf_(v2 - v0), e3 = expf_(v3 - v0), inv = 1.0f / (1.0f + e1 + e2 + e3);
                const int lrow = wave * 8 + pass * 4 + lane;
                pe[lrow * 4 + 0] = i0; pe[lrow * 4 + 1] = i1; pe[lrow * 4 + 2] = i2; pe[lrow * 4 + 3] = i3;
                pw[lrow * 4 + 0] = inv; pw[lrow * 4 + 1] = e1 * inv; pw[lrow * 4 + 2] = e2 * inv; pw[lrow * 4 + 3] = e3 * inv;
                plr[lrow * 4 + 0] = atomicAdd((int*)(hist + i0), 1); plr[lrow * 4 + 1] = atomicAdd((int*)(hist + i1), 1);
                plr[lrow * 4 + 2] = atomicAdd((int*)(hist + i2), 1); plr[lrow * 4 + 3] = atomicAdd((int*)(hist + i3), 1);
            }
            LDS_WAIT(); asm volatile("" ::: "memory");
        }
        __syncthreads();
        if (tid < 32) base[tid] = (int)__hip_atomic_fetch_add(cnt + tid, (unsigned)hist[tid], __ATOMIC_RELAXED, __HIP_MEMORY_SCOPE_AGENT);
        __syncthreads();
        if (tid < 256) { const int lrow = tid >> 2, sl = tid & 3; const int m = rb * 64 + lrow; const int ee = pe[lrow * 4 + sl];
            TE[m * 4 + sl] = ee; TW[m * 4 + sl] = pw[lrow * 4 + sl]; TR[m * 4 + sl] = base[ee] + plr[lrow * 4 + sl]; }
    }
}

__device__ __forceinline__ int moe_tables(const Ptrs& P, LAS unsigned char* lds, int layer, int tid) {
    LAS unsigned char* lc = lds + LDSCTL_OFF;
    LAS int* tile_exp = (LAS int*)(lc + LC_TILE); LAS int* seg = (LAS int*)(lc + LC_SEG); LAS int* tot = (LAS int*)(lc + LC_TOTAL);
    const unsigned* cnt = (const unsigned*)(P.ws + WS_CTL) + CW_CNT + layer * 64;
    __syncthreads();
    if (tid < 32) {
        int ts = 0, mine = 0;
        for (int e = 0; e < 32; ++e) { const int c = (int)__hip_atomic_load(cnt + e, __ATOMIC_RELAXED, __HIP_MEMORY_SCOPE_AGENT); const int nt = (c + 255) >> 8; if (e < tid) ts += nt; if (e == tid) mine = nt; }
        seg[tid] = ts * 256;
        for (int i = 0; i < mine; ++i) tile_exp[ts + i] = tid;
        if (tid == 31) tot[0] = ts + mine;
    }
    __syncthreads();
    return tot[0];
}

__device__ __forceinline__ void p8_scatter(const Ptrs& P, LAS unsigned char* lds, int layer, int tid, int lane, int wave, int blk, int G) {
    (void)moe_tables(P, lds, layer, tid);
    const LAS int* seg = (const LAS int*)(lds + LDSCTL_OFF + LC_SEG);
    const bf16* H = (const bf16*)(P.ws + WS_H); bf16* HS = (bf16*)(P.ws + WS_HS);
    const int* TE = (const int*)(P.ws + WS_ROUTE + RT_E); const float* TW = (const float*)(P.ws + WS_ROUTE + RT_W); const int* TR = (const int*)(P.ws + WS_ROUTE + RT_RANK);
    int* POS = (int*)(P.ws + WS_ROUTE + RT_POS); float* GATE = (float*)(P.ws + WS_ROUTE + RT_GATE);
    for (int m = blk * 8 + wave; m < MTOK; m += G * 8) {
        const v4u* src = (const v4u*)(H + (size_t)m * 1024);
        const v4u a = src[lane], b2 = src[64 + lane];
#pragma unroll
        for (int sl = 0; sl < 4; ++sl) {
            const int e = TE[m * 4 + sl]; const int pos = seg[e] + TR[m * 4 + sl];
            if (lane == 0) { POS[m * 4 + sl] = pos; GATE[pos] = TW[m * 4 + sl]; }
            v4u* dst = (v4u*)(HS + (size_t)pos * 1024); dst[lane] = a; dst[64 + lane] = b2;
        }
    }
}

template <bool FINAL>
__device__ __forceinline__ void p11_moe_combine(const Ptrs& P, LAS unsigned char* lds, int layer, const float* x1, float* xout, int tid, int lane, int wave, int blk, int G) {
    LAS float* eg = (LAS float*)lds; LAS float* sh = eg + 1024; LAS float* gf = sh + 1024;
    const bf16* EO = (const bf16*)(P.ws + WS_EO); const int* POS = (const int*)(P.ws + WS_ROUTE + RT_POS);
    const float* mod = (const float*)(P.ws + WS_MOD);
    bf16* H = (bf16*)(P.ws + WS_H);
    for (int rb = blk; rb < 256; rb += G) {
        const int b = rb >> 5;
        __syncthreads();
        if (FINAL) { for (int k = tid; k < 1024; k += 512) { eg[k] = P.in[32][k]; sh[k] = 0.f; } }
        else load_mod_vec<false>(P, eg, sh, P.in[4] + (layer + 1) * 1024, layer + 1, b, 0, tid);
        for (int k = tid; k < 1024; k += 512) gf[k] = mod[((size_t)layer * 8 + b) * 6144 + 5120 + k];
        __syncthreads();
        for (int i = 0; i < 8; ++i) { const int m = rb * 64 + wave * 8 + i;
            const f32x4* xr = (const f32x4*)(x1 + (size_t)m * 1024) + lane;
            f32x4 v[4], s[4];
#pragma unroll
            for (int j = 0; j < 4; ++j) { v[j] = xr[64 * j]; s[j] = (f32x4){0.f, 0.f, 0.f, 0.f}; }
#pragma unroll
            for (int sl = 0; sl < 4; ++sl) { const int pos = POS[m * 4 + sl]; const u32x2* er = (const u32x2*)(EO + (size_t)pos * 1024) + lane;
#pragma unroll
                for (int j = 0; j < 4; ++j) { const u32x2 w = er[64 * j]; s[j].x += bflo(w.x); s[j].y += bfhi(w.x); s[j].z += bflo(w.y); s[j].w += bfhi(w.y); } }
#pragma unroll
            for (int j = 0; j < 4; ++j) { const f32x4 g = *(const LAS f32x4*)(gf + 4 * lane + 256 * j); v[j] = v[j] + g * s[j]; }
            const float rstd = row_rstd(v);
            if (FINAL) {
                f32x4* orow = (f32x4*)(P.out + (size_t)m * 1024) + lane;
#pragma unroll
                for (int j = 0; j < 4; ++j) { const f32x4 g = *(const LAS f32x4*)(eg + 4 * lane + 256 * j); orow[64 * j] = v[j] * rstd * g; }
            } else {
                f32x4* xo = (f32x4*)(xout + (size_t)m * 1024) + lane;
#pragma unroll
                for (int j = 0; j < 4; ++j) xo[64 * j] = v[j];
                store_h_row(H + (size_t)m * 1024, v, rstd, eg, sh, lane);
            }
        }
    }
}
constexpr int AT_KP = 136, AT_VP = 160;
constexpr int AT_K_OFF = 0, AT_V_OFF = 64 * AT_KP * 2, AT_B_OFF = AT_V_OFF + 64 * AT_VP * 2, AT_X_OFF = AT_B_OFF + 4096 * 4, AT_END = AT_X_OFF + 4 * 64 * 64 * 4;
static_assert(AT_END <= SCR_BYTES, "attention LDS");
__device__ __forceinline__ bf16x8 vtr_pair(const LAS bf16* p) {
    typedef short v4i16_t __attribute__((ext_vector_type(4)));
    const s16x4 lo = __builtin_bit_cast(s16x4, __builtin_amdgcn_ds_read_tr16_b64_v4i16((LAS v4i16_t*)p));
    const s16x4 hi = __builtin_bit_cast(s16x4, __builtin_amdgcn_ds_read_tr16_b64_v4i16((LAS v4i16_t*)(p + 8 * AT_VP)));
    return (bf16x8){lo[0], lo[1], lo[2], lo[3], hi[0], hi[1], hi[2], hi[3]};
}
__device__ __forceinline__ void attn_phase(const Ptrs& P, LAS unsigned char* lds, int tid, int lane, int wave, int blk, int G) {
    LAS bf16* Kt = (LAS bf16*)(lds + AT_K_OFF); LAS bf16* Vt = (LAS bf16*)(lds + AT_V_OFF);
    LAS float* biasL = (LAS float*)(lds + AT_B_OFF); LAS float* xch = (LAS float*)(lds + AT_X_OFF);
    const bf16* Qg = (const bf16*)(P.ws + WS_P); const bf16* Kg = Qg + (size_t)MTOK * 1024; const bf16* Vg = Kg + (size_t)MTOK * 1024;
    bf16* AO = (bf16*)(P.ws + WS_YMIX);
    const float* biasT = (const float*)(P.ws + WS_BIAS);
    const int r32 = lane & 31, hi = lane >> 5, mp = wave & 1, qs = wave >> 1;
    float lam_full;
    { const float* lm = P.in[29]; const float s1 = wave_sum(lm[lane] * lm[64 + lane]), s2 = wave_sum(lm[128 + lane] * lm[192 + lane]); lam_full = expf_(s1) - expf_(s2) + LAM_INIT; }
    const int trow = 4 * hi + ((lane & 15) >> 2), tcol = 16 * ((lane >> 4) & 1) + 4 * (lane & 3);
    for (int unit = blk; unit < 1024; unit += G) {
        const int bh = unit >> 4, qb = unit & 15, b = bh >> 3, h = bh & 7, q0 = qb * 128;
        const size_t rowb = (size_t)b * 2048;
        __syncthreads();
        for (int i = tid; i < 1024; i += 512) *(LAS f32x4*)(biasL + 4 * i) = *(const f32x4*)(biasT + h * 4096 + 4 * i);
        const int qrow = q0 + qs * 32 + r32;
        bf16x8 qf[4];
#pragma unroll
        for (int ks = 0; ks < 4; ++ks) qf[ks] = *(const bf16x8*)(Qg + (rowb + qrow) * 1024 + h * 128 + mp * 64 + 16 * ks + 8 * hi);
        f32x16 oT[4];
#pragma unroll
        for (int d = 0; d < 4; ++d)
#pragma unroll
            for (int r = 0; r < 16; ++r) oT[d][r] = 0.f;
        float mrow = -1e30f, lsum = 0.f;
        v4u pk[2], pv[2];
        auto issue = [&](int kt) {
#pragma unroll
            for (int i = 0; i < 2; ++i) { const int idx = tid + 512 * i, row = idx >> 4, c16 = idx & 15;
                pk[i] = *(const v4u*)(Kg + (rowb + kt * 64 + row) * 1024 + h * 128 + c16 * 8);
                pv[i] = *(const v4u*)(Vg + (rowb + kt * 64 + row) * 1024 + h * 128 + c16 * 8); }
        };
        issue(0);
        for (int kt = 0; kt < 32; ++kt) {
            __syncthreads();
#pragma unroll
            for (int i = 0; i < 2; ++i) { const int idx = tid + 512 * i, row = idx >> 4, c16 = idx & 15;
                *(LAS v4u*)(Kt + row * AT_KP + c16 * 8) = pk[i]; *(LAS v4u*)(Vt + row * AT_VP + c16 * 8) = pv[i]; }
            __syncthreads();
            if (kt + 1 < 32) issue(kt + 1);
            f32x16 p0, p1;
#pragma unroll
            for (int r = 0; r < 16; ++r) { p0[r] = 0.f; p1[r] = 0.f; }
#pragma unroll
            for (int ks = 0; ks < 4; ++ks) {
                const bf16x8 a0 = *(const LAS bf16x8*)(Kt + r32 * AT_KP + mp * 64 + 16 * ks + 8 * hi);
                const bf16x8 a1 = *(const LAS bf16x8*)(Kt + (32 + r32) * AT_KP + mp * 64 + 16 * ks + 8 * hi);
                p0 = __builtin_amdgcn_mfma_f32_32x32x16_bf16(a0, qf[ks], p0, 0, 0, 0);
                p1 = __builtin_amdgcn_mfma_f32_32x32x16_bf16(a1, qf[ks], p1, 0, 0, 0);
            }
            const int k0 = kt * 64, qw0 = q0 + qs * 32;
            if (k0 - (qw0 + 31) >= 128) { const float cb = biasL[2047 + 128];
#pragma unroll
                for (int r = 0; r < 16; ++r) { p0[r] += cb; p1[r] += cb; } }
            else if (qw0 - (k0 + 63) >= 128) { const float cb = biasL[2047 - 128];
#pragma unroll
                for (int r = 0; r < 16; ++r) { p0[r] += cb; p1[r] += cb; } }
            else { const LAS float* bp = biasL + (k0 - qrow + 2047);
#pragma unroll
                for (int r = 0; r < 16; ++r) { p0[r] += bp[crow(r, hi)]; p1[r] += bp[32 + crow(r, hi)]; } }
            float mx = fmaxf(p0[0], p1[0]);
#pragma unroll
            for (int r = 1; r < 16; ++r) mx = fmaxf(mx, fmaxf(p0[r], p1[r]));
            mx = fmaxf(mx, __shfl_xor(mx, 32));
            const float mnew = fmaxf(mrow, mx), alpha = __builtin_amdgcn_exp2f(mrow - mnew);
            mrow = mnew;
            float ps = 0.f;
#pragma unroll
            for (int r = 0; r < 16; ++r) { p0[r] = __builtin_amdgcn_exp2f(p0[r] - mnew); p1[r] = __builtin_amdgcn_exp2f(p1[r] - mnew); ps += p0[r] + p1[r]; }
            lsum = lsum * alpha + ps;
#pragma unroll
            for (int d = 0; d < 4; ++d)
#pragma unroll
                for (int r = 0; r < 16; ++r) oT[d][r] *= alpha;
            bf16x8 pb[4];
            pb[0] = pack8(p0[0], p0[1], p0[2], p0[3], p0[4], p0[5], p0[6], p0[7]); pb[1] = pack8(p0[8], p0[9], p0[10], p0[11], p0[12], p0[13], p0[14], p0[15]);
            pb[2] = pack8(p1[0], p1[1], p1[2], p1[3], p1[4], p1[5], p1[6], p1[7]); pb[3] = pack8(p1[8], p1[9], p1[10], p1[11], p1[12], p1[13], p1[14], p1[15]);
#pragma unroll
            for (int d = 0; d < 4; ++d)
#pragma unroll
                for (int st = 0; st < 4; ++st) {
                    const bf16x8 va = vtr_pair(Vt + (16 * st + trow) * AT_VP + 32 * d + tcol);
                    oT[d] = __builtin_amdgcn_mfma_f32_32x32x16_bf16(va, pb[st], oT[d], 0, 0, 0);
                }
        }
        lsum += __shfl_xor(lsum, 32);
        const float inv = 1.0f / lsum;
        __syncthreads();
        if (mp == 1) {
#pragma unroll
            for (int d = 0; d < 4; ++d)
#pragma unroll
                for (int r = 0; r < 16; ++r) xch[(qs * 64 + d * 16 + r) * 64 + lane] = oT[d][r] * inv;
        }
        __syncthreads();
        if (mp == 0) {
            float ss = 0.f;
#pragma unroll
            for (int d = 0; d < 4; ++d)
#pragma unroll
                for (int r = 0; r < 16; ++r) { const float o = oT[d][r] * inv - lam_full * xch[(qs * 64 + d * 16 + r) * 64 + lane]; oT[d][r] = o; ss += o * o; }
            ss += __shfl_xor(ss, 32);
            const float sc = (1.0f - LAM_INIT) / sqrtf(ss * (1.0f / 128.0f) + 1e-6f);
            bf16* orow = AO + (rowb + qrow) * 1024 + h * 128;
#pragma unroll
            for (int d = 0; d < 4; ++d)
#pragma unroll
                for (int g = 0; g < 4; ++g) { const int dv = 32 * d + 8 * g + 4 * hi; const f32x4 sg = *(const f32x4*)(P.in[30] + dv);
                    u32x2 w; w.x = pg8::cvt_pk_bf16(oT[d][4 * g] * sc * sg.x, oT[d][4 * g + 1] * sc * sg.y); w.y = pg8::cvt_pk_bf16(oT[d][4 * g + 2] * sc * sg.z, oT[d][4 * g + 3] * sc * sg.w);
                    *(u32x2*)(orow + dv) = w; }
        }
    }
    __syncthreads();
}
#ifndef MK_N_LAUNCHES
#define MK_N_LAUNCHES 1
#endif
constexpr int N_PHASES = 20;
struct Args { Ptrs p; int ph_lo, ph_hi; };
__global__ void __launch_bounds__(512, 2) mk_fwd(Args args) {
    extern __shared__ __attribute__((aligned(16))) unsigned char lds_raw[];
    LAS unsigned char* lds = (LAS unsigned char*)lds_raw;
    const Ptrs& P = args.p;
    const int tid = threadIdx.x, lane = tid & 63, wave = __builtin_amdgcn_readfirstlane(tid >> 6), blk = blockIdx.x, G = gridDim.x;
    const int lo = args.ph_lo, hi = args.ph_hi;
    unsigned char* ws = P.ws;
    for (int u = tid; u < (LDS_BYTES - LDSCTL_OFF) / 4; u += 512) ((LAS unsigned*)(lds + LDSCTL_OFF))[u] = 0u;
    __syncthreads();
    XcdBarrier bar; bar.bar = (unsigned*)(ws + WS_CTL) + CW_BAR; bar.x = 0; bar.st = nullptr;
    if (hi - lo > 1) bar = xcd_barrier_post((unsigned*)(ws + WS_CTL) + CW_BAR, (volatile LAS unsigned*)(lds + LDSCTL_OFF + LC_MISC) + 8);
#define IN(k) (lo <= (k) && (k) < hi)
#define SEAM(k) do { if (IN(k) && IN((k) + 1)) xcd_barrier(bar); } while (0)
    bf16* const Hb = (bf16*)(ws + WS_H);
    float* const XA = (float*)(ws + WS_XA); float* const XB = (float*)(ws + WS_XB);
    const float* const mod = (const float*)(ws + WS_MOD);

    if (IN(0)) { p0_prologue(P, lds, tid, lane, wave, blk, G); } SEAM(0);
    if (IN(1)) { p1_norm0(P, lds, tid, lane, wave, blk, G); } SEAM(1);
    if (IN(2)) {
        pg8::Gemm g{Hb, (const bf16*)(ws + WS_WAB), MTOK, PCOLS, 1024}; pg8::StaticOrder S; S.init(MTOK, PCOLS, G, blk);
        pg8::EpiBf16<0> E{(bf16*)(ws + WS_P), PCOLS, nullptr, 0, 0, 1.f};
        pg8::gemm_phase<pg8::EpiBf16<0>, pg8::StaticOrder, true, true>(lds, g, S, E);
    } SEAM(2);
    if (IN(3)) { p3_rwkv_prep(P, lds, tid, lane, wave, blk, G); } SEAM(3);
    if (IN(4)) {
        for (int u = blk; u < 192; u += G) { if (u < 128) rwkv_scan_unit(P, lds, u, tid, lane, wave); else hgrn_unit(P, lds, u - 128, tid, lane, wave); }
    } SEAM(4);
    if (IN(5)) { p5_combine(P, lane, wave, blk, G); } SEAM(5);
    if (IN(6)) {
        pg8::Gemm g{(const bf16*)(ws + WS_YMIX), (const bf16*)(ws + WS_WOUT), MTOK, 1024, 1024}; pg8::StaticOrder S; S.init(MTOK, 1024, G, blk);
        pg8::EpiResGate E{P.in[0], XA, mod + 2048};
        pg8::gemm_phase<pg8::EpiResGate, pg8::StaticOrder, true, true>(lds, g, S, E);
    } SEAM(6);
    if (IN(7)) { p7_router(P, lds, 0, XA, tid, lane, wave, blk, G); } SEAM(7);
    if (IN(8)) { p8_scatter(P, lds, 0, tid, lane, wave, blk, G); } SEAM(8);
    if (IN(9)) {
        const int MT = moe_tables(P, lds, 0, tid);
        pg8::Gemm g{(const bf16*)(ws + WS_HS), (const bf16*)(ws + WS_W1T), ROWS_PAD, 2048, 1024};
        pg8::GroupedOrder S{MT * 8, G, blk, 8, (const LAS int*)(lds + LDSCTL_OFF + LC_TILE)};
        pg8::EpiSwiglu E{(bf16*)(ws + WS_ACT), P.in[9]};
        pg8::gemm_phase<pg8::EpiSwiglu, pg8::GroupedOrder, true, true>(lds, g, S, E);
    } SEAM(9);
    if (IN(10)) {
        const int MT = moe_tables(P, lds, 0, tid);
        pg8::Gemm g{(const bf16*)(ws + WS_ACT), (const bf16*)(ws + WS_W2T), ROWS_PAD, 1024, 1024};
        pg8::GroupedOrder S{MT * 4, G, blk, 4, (const LAS int*)(lds + LDSCTL_OFF + LC_TILE)};
        pg8::EpiMoeOut E{(bf16*)(ws + WS_EO), P.in[11], (const float*)(ws + WS_ROUTE + RT_GATE)};
        pg8::gemm_phase<pg8::EpiMoeOut, pg8::GroupedOrder, true, true>(lds, g, S, E);
    } SEAM(10);
    if (IN(11)) { p11_moe_combine<false>(P, lds, 0, XA, XB, tid, lane, wave, blk, G); } SEAM(11);
    if (IN(12)) {
        pg8::Gemm g{Hb, (const bf16*)(ws + WS_WQKV), MTOK, 3072, 1024}; pg8::StaticOrder S; S.init(MTOK, 3072, G, blk);
        pg8::EpiBf16<0> E{(bf16*)(ws + WS_P), 1024, nullptr, 1024, (size_t)MTOK * 1024, QSCALE};
        pg8::gemm_phase<pg8::EpiBf16<0>, pg8::StaticOrder, true, true>(lds, g, S, E);
    } SEAM(12);
    if (IN(13)) { attn_phase(P, lds, tid, lane, wave, blk, G); } SEAM(13);
    if (IN(14)) {
        pg8::Gemm g{(const bf16*)(ws + WS_YMIX), (const bf16*)(ws + WS_WAO), MTOK, 1024, 1024}; pg8::StaticOrder S; S.init(MTOK, 1024, G, blk);
        pg8::EpiResGate E{XB, XA, mod + 8 * 6144 + 2048};
        pg8::gemm_phase<pg8::EpiResGate, pg8::StaticOrder, true, true>(lds, g, S, E);
    } SEAM(14);
    if (IN(15)) { p7_router(P, lds, 1, XA, tid, lane, wave, blk, G); } SEAM(15);
    if (IN(16)) { p8_scatter(P, lds, 1, tid, lane, wave, blk, G); } SEAM(16);
    if (IN(17)) {
        const int MT = moe_tables(P, lds, 1, tid);
        pg8::Gemm g{(const bf16*)(ws + WS_HS), (const bf16*)(ws + WS_W1T) + (size_t)32 * 2048 * 1024, ROWS_PAD, 2048, 1024};
        pg8::GroupedOrder S{MT * 8, G, blk, 8, (const LAS int*)(lds + LDSCTL_OFF + LC_TILE)};
        pg8::EpiSwiglu E{(bf16*)(ws + WS_ACT), P.in[9] + 32 * 2048};
        pg8::gemm_phase<pg8::EpiSwiglu, pg8::GroupedOrder, true, true>(lds, g, S, E);
    } SEAM(17);
    if (IN(18)) {
        const int MT = moe_tables(P, lds, 1, tid);
        pg8::Gemm g{(const bf16*)(ws + WS_ACT), (const bf16*)(ws + WS_W2T) + (size_t)32 * 1024 * 1024, ROWS_PAD, 1024, 1024};
        pg8::GroupedOrder S{MT * 4, G, blk, 4, (const LAS int*)(lds + LDSCTL_OFF + LC_TILE)};
        pg8::EpiMoeOut E{(bf16*)(ws + WS_EO), P.in[11] + 32 * 1024, (const float*)(ws + WS_ROUTE + RT_GATE)};
        pg8::gemm_phase<pg8::EpiMoeOut, pg8::GroupedOrder, true, true>(lds, g, S, E);
    } SEAM(18);
    if (IN(19)) { p11_moe_combine<true>(P, lds, 1, XA, nullptr, tid, lane, wave, blk, G); }
#undef IN
#undef SEAM
}

extern "C" void kernel_launch(void* const* d_in, const int* in_sizes, int n_in, void* d_out, int out_size, void* d_ws, size_t ws_size, hipStream_t stream) {
    static int grid = 0;
    if (grid == 0) {
        if (n_in != 33 || out_size != MTOK * DM || ws_size < WS_END) { fprintf(stderr, "kernel_launch: unexpected problem (n_in %d, out %d, ws %zu)\n", n_in, out_size, ws_size); grid = -1; return; }
        int dev = 0, cus = 0, per_cu = 0;
        if (hipGetDevice(&dev) != hipSuccess || hipDeviceGetAttribute(&cus, hipDeviceAttributeMultiprocessorCount, dev) != hipSuccess) { grid = -1; return; }
        if (hipFuncSetAttribute((const void*)mk_fwd, hipFuncAttributeMaxDynamicSharedMemorySize, LDS_BYTES) != hipSuccess) { fprintf(stderr, "kernel_launch: hipFuncSetAttribute failed\n"); grid = -1; return; }
        if (hipOccupancyMaxActiveBlocksPerMultiprocessor(&per_cu, (const void*)mk_fwd, 512, LDS_BYTES) != hipSuccess || per_cu < 1) { fprintf(stderr, "kernel_launch: occupancy query says %d\n", per_cu); }
        (void)hipGetLastError();
        grid = cus;
    }
    if (grid < 0) return;
    (void)in_sizes;
    if (hipMemsetAsync((char*)d_ws + WS_CTL, 0, CTL_ZERO_BYTES, stream) != hipSuccess) return;
    Args a{};
    for (int i = 0; i < 33; ++i) a.p.in[i] = (const float*)d_in[i];
    a.p.out = (float*)d_out; a.p.ws = (unsigned char*)d_ws;
#if MK_N_LAUNCHES == 1
    a.ph_lo = 0; a.ph_hi = N_PHASES;
    hipLaunchKernelGGL(mk_fwd, dim3(grid), dim3(512), LDS_BYTES, stream, a);
#else
    for (int k = 0; k < N_PHASES; ++k) { a.ph_lo = k; a.ph_hi = k + 1; hipLaunchKernelGGL(mk_fwd, dim3(grid), dim3(512), LDS_BYTES, stream, a); }
#endif
}
```

```cpp
#include <hip/hip_runtime.h>
#include <cstdio>
#include <cstdint>
#define MK_N_LAUNCHES 1
namespace pg8 {
#define PG8_LAS __attribute__((address_space(3)))
typedef unsigned short bf16_t;
typedef short bf16x8 __attribute__((ext_vector_type(8)));
typedef float f32x4 __attribute__((ext_vector_type(4)));
typedef unsigned u32x4 __attribute__((ext_vector_type(4)));
constexpr int BM = 256, BK = 64, HALF = 128, HTB = HALF * BK * 2  , STAGE_BYTES = 8 * HTB, NXCD = 8, WGM = 8;

__host__ __device__ __forceinline__ int lds_byte(int r, int c) { const int st = (r >> 4) * 2 + (c >> 5), rr = r & 15, cc = c & 31, ob = rr * 64 + cc * 2; return st * 1024 + (ob ^ (((ob >> 9) & 1) << 5)); }
__host__ __device__ __forceinline__ void stage_rc(int b, int& R, int& C) { const int st = b / 1024, sb = b % 1024, swz = sb ^ (((sb >> 9) & 1) << 5); R = (st >> 1) * 16 + swz / 64; C = (st & 1) * 32 + (swz % 64) / 2; }
__host__ __device__ __forceinline__ int perm32(int rho) { const int n = rho >> 4, i = rho & 15; return 8 * (i >> 2) + 4 * n + (i & 3); }

struct Unit { int pm, pn; int ga = 0; int vr = 256; };
struct Gemm { const bf16_t* A; const bf16_t* Bt; int M, N, K; const int* aidx; int amax; };

struct StaticOrder {
    int nM, nN, nwg, G, c;
    __host__ __device__ void init(int M, int N, int G_, int c_) { nM = M / BM; nN = N / BM; nwg = nM * nN; G = G_; c = c_; }
    __host__ __device__ bool next(int i, Unit& u) const {
        const long L = (long)i * G + c; if (L >= nwg) return false;
        int wgid = (int)L; { const int q = nwg / NXCD, r = nwg % NXCD, xcd = wgid % NXCD, off = wgid / NXCD; wgid = (xcd < r ? xcd * (q + 1) : r * (q + 1) + (xcd - r) * q) + off; }
        const int nig = WGM * nN, gid = wgid / nig, fm = gid * WGM, gsz = (nM - fm) < WGM ? (nM - fm) : WGM;
        u.pm = fm + ((wgid % nig) % gsz); u.pn = (wgid % nig) / gsz; return true;
    }
    __device__ __forceinline__ void a_ready(const Unit&) const {}
    __device__ __forceinline__ void done(const Unit&) const {}
};

__device__ __forceinline__ unsigned cvt_pk_bf16(float lo, float hi) { unsigned r; asm volatile("v_cvt_pk_bf16_f32 %0, %1, %2" : "=v"(r) : "v"(lo), "v"(hi)); return r; }
typedef float f32x2 __attribute__((ext_vector_type(2)));
__device__ __forceinline__ f32x2 gelu_pk(f32x2 v) {
    const f32x2 av = __builtin_elementwise_abs(v), d = av * 0.2316418882f + 1.0f;
    f32x2 t; t.x = __builtin_amdgcn_rcpf(d.x); t.y = __builtin_amdgcn_rcpf(d.y);
    f32x2 q = t * 0.5307027145f + (-0.7265760135f); q = q * t + 0.7107068705f; q = q * t + (-0.142248368f); q = q * t + 0.127414796f; q = q * t;
    const f32x2 s = (v * v) * (-0.72134752044f);
    f32x2 e; e.x = __builtin_amdgcn_exp2f(s.x); e.y = __builtin_amdgcn_exp2f(s.y);
    const f32x2 m = v * (q * e), r = v - m;
    f32x2 o; o.x = v.x < 0.f ? m.x : r.x; o.y = v.y < 0.f ? m.y : r.y; return o;
}

template <int ACT  > struct EpiBf16 {
    static constexpr bool PERM = true, AFTER_DRAIN = false; static_assert(ACT == 0 || ACT == 1, "EpiBf16: ACT is 0 (none) or 1 (gelu_pk)");
    bf16_t* O; int ldc; const float* bias; int split_cols; size_t split_stride; float scale0;
    __device__ __forceinline__ void operator()(const f32x4 (&acc)[2][2][4][2], const Unit& u, int wr, int wc, int fr, int fq) const {
        const int row0 = u.pm * BM + wr * 64 + fr; int colt = u.pn * BM; bf16_t* base = O;
        float sc = 1.f; if (split_cols) { const int t = colt / split_cols; base += (size_t)t * split_stride; colt -= t * split_cols; if (t == 0) sc = scale0; }
        const int col0 = colt + wc * 32 + 8 * fq, bcol0 = u.pn * BM + wc * 32 + 8 * fq;
        f32x4 bv[2][2];
#pragma unroll
        for (int bj = 0; bj < 2; ++bj)
#pragma unroll
            for (int n = 0; n < 2; ++n) bv[bj][n] = bias ? *(const f32x4*)(bias + bcol0 + bj * HALF + 4 * n) : (f32x4){0.f, 0.f, 0.f, 0.f};
#pragma unroll
        for (int ai = 0; ai < 2; ++ai)
#pragma unroll
            for (int m = 0; m < 4; ++m) { bf16_t* rowp = base + (size_t)(row0 + ai * HALF + m * 16) * ldc + col0;
#pragma unroll
                for (int bj = 0; bj < 2; ++bj) { f32x4 v0 = acc[ai][bj][m][0] + bv[bj][0], v1 = acc[ai][bj][m][1] + bv[bj][1];
                    if (ACT == 1) { f32x2 a = gelu_pk((f32x2){v0[0], v0[1]}), b = gelu_pk((f32x2){v0[2], v0[3]}), c = gelu_pk((f32x2){v1[0], v1[1]}), d = gelu_pk((f32x2){v1[2], v1[3]});
                        v0 = (f32x4){a.x, a.y, b.x, b.y}; v1 = (f32x4){c.x, c.y, d.x, d.y}; }
                    v0 = v0 * sc; v1 = v1 * sc; u32x4 w; w.x = cvt_pk_bf16(v0[0], v0[1]); w.y = cvt_pk_bf16(v0[2], v0[3]); w.z = cvt_pk_bf16(v1[0], v1[1]); w.w = cvt_pk_bf16(v1[2], v1[3]);
                    *(u32x4*)(rowp + bj * HALF) = w; } }
    }
};
template <bool BASE_BF16> struct EpiResGate {
    static constexpr bool PERM = true, AFTER_DRAIN = false;
    const void* base; bf16_t* out; const float* gate;
    __device__ __forceinline__ void operator()(const f32x4 (&acc)[2][2][4][2], const Unit& u, int wr, int wc, int fr, int fq) const {
        const int row0 = u.pm * BM + wr * 64 + fr, col0 = u.pn * BM + wc * 32 + 8 * fq; const int b = u.pm >> 3;
        f32x4 gv[2][2];
#pragma unroll
        for (int bj = 0; bj < 2; ++bj)
#pragma unroll
            for (int n = 0; n < 2; ++n) gv[bj][n] = *(const f32x4*)(gate + (size_t)b * 6144 + col0 + bj * HALF + 4 * n);
#pragma unroll
        for (int ai = 0; ai < 2; ++ai)
#pragma unroll
            for (int m = 0; m < 4; ++m) { const size_t off = (size_t)(row0 + ai * HALF + m * 16) * 1024 + col0;
#pragma unroll
                for (int bj = 0; bj < 2; ++bj) { f32x4 b0, b1;
                    if constexpr (BASE_BF16) { const u32x4 w = *(const u32x4*)((const bf16_t*)base + off + bj * HALF);
                        b0 = (f32x4){__uint_as_float(w.x << 16), __uint_as_float(w.x & 0xffff0000u), __uint_as_float(w.y << 16), __uint_as_float(w.y & 0xffff0000u)};
                        b1 = (f32x4){__uint_as_float(w.z << 16), __uint_as_float(w.z & 0xffff0000u), __uint_as_float(w.w << 16), __uint_as_float(w.w & 0xffff0000u)}; }
                    else { b0 = *(const f32x4*)((const float*)base + off + bj * HALF); b1 = *(const f32x4*)((const float*)base + off + bj * HALF + 4); }
                    const f32x4 v0 = b0 + gv[bj][0] * acc[ai][bj][m][0], v1 = b1 + gv[bj][1] * acc[ai][bj][m][1];
                    u32x4 w; w.x = cvt_pk_bf16(v0[0], v0[1]); w.y = cvt_pk_bf16(v0[2], v0[3]); w.z = cvt_pk_bf16(v1[0], v1[1]); w.w = cvt_pk_bf16(v1[2], v1[3]);
                    *(u32x4*)(out + off + bj * HALF) = w; } }
    }
};
struct EpiSwiglu {
    static constexpr bool PERM = true, AFTER_DRAIN = false;
    bf16_t* O; const float* bias;
    __device__ __forceinline__ void operator()(const f32x4 (&acc)[2][2][4][2], const Unit& u, int wr, int wc, int fr, int fq) const {
        const int row0 = u.pm * BM + wr * 64 + fr; const int bcol0 = u.pn * BM + wc * 32 + 8 * fq;
        const int ocol0 = (u.pn & 7) * 128 + wc * 16 + 4 * fq;
        f32x4 bv[2][2];
#pragma unroll
        for (int bj = 0; bj < 2; ++bj)
#pragma unroll
            for (int n = 0; n < 2; ++n) bv[bj][n] = *(const f32x4*)(bias + bcol0 + bj * HALF + 4 * n);
#pragma unroll
        for (int ai = 0; ai < 2; ++ai)
#pragma unroll
            for (int m = 0; m < 4; ++m) { bf16_t* rowp = O + (size_t)(row0 + ai * HALF + m * 16) * 1024 + ocol0;
#pragma unroll
                for (int bj = 0; bj < 2; ++bj) { const f32x4 v0 = acc[ai][bj][m][0] + bv[bj][0], v1 = acc[ai][bj][m][1] + bv[bj][1];
                    float g[4] = {v0[0], v0[2], v1[0], v1[2]}, l[4] = {v0[1], v0[3], v1[1], v1[3]}, a[4];
#pragma unroll
                    for (int i = 0; i < 4; ++i) { const float xg = fminf(g[i], 7.0f), xl = fminf(fmaxf(l[i], -7.0f), 7.0f);
                        const float e = __builtin_amdgcn_exp2f(xg * (-1.702f * 1.4426950408889634f)); a[i] = xg * __builtin_amdgcn_rcpf(1.0f + e) * (xl + 1.0f); }
                    typedef unsigned u32x2 __attribute__((ext_vector_type(2)));
                    u32x2 w; w.x = cvt_pk_bf16(a[0], a[1]); w.y = cvt_pk_bf16(a[2], a[3]);
                    *(u32x2*)(rowp + bj * 64) = w; } }
    }
};
struct EpiMoeOut {
    static constexpr bool PERM = true, AFTER_DRAIN = false;
    bf16_t* O; const float* bias;
    __device__ __forceinline__ void operator()(const f32x4 (&acc)[2][2][4][2], const Unit& u, int wr, int wc, int fr, int fq) const {
        const int row0 = u.pm * BM + wr * 64 + fr; const int bcol0 = u.pn * BM + wc * 32 + 8 * fq;
        const int ocol0 = (u.pn & 3) * BM + wc * 32 + 8 * fq;
        f32x4 bv[2][2];
#pragma unroll
        for (int bj = 0; bj < 2; ++bj)
#pragma unroll
            for (int n = 0; n < 2; ++n) bv[bj][n] = *(const f32x4*)(bias + bcol0 + bj * HALF + 4 * n);
#pragma unroll
        for (int ai = 0; ai < 2; ++ai)
#pragma unroll
            for (int m = 0; m < 4; ++m) { const int row = row0 + ai * HALF + m * 16; bf16_t* rowp = O + (size_t)row * 1024 + ocol0;
#pragma unroll
                for (int bj = 0; bj < 2; ++bj) { const f32x4 v0 = acc[ai][bj][m][0] + bv[bj][0], v1 = acc[ai][bj][m][1] + bv[bj][1];
                    u32x4 w; w.x = cvt_pk_bf16(v0[0], v0[1]); w.y = cvt_pk_bf16(v0[2], v0[3]); w.z = cvt_pk_bf16(v1[0], v1[1]); w.w = cvt_pk_bf16(v1[2], v1[3]);
                    *(u32x4*)(rowp + bj * HALF) = w; } }
    }
};
struct EpiP {
    static constexpr bool PERM = true, AFTER_DRAIN = false;
    bf16_t* O; int ldc; const float* lbraw;
    __device__ __forceinline__ void operator()(const f32x4 (&acc)[2][2][4][2], const Unit& u, int wr, int wc, int fr, int fq) const {
        const int row0 = u.pm * BM + wr * 64 + fr; const int col0 = u.pn * BM + wc * 32 + 8 * fq;
        const int kind = u.pn >> 1;
        float om[2][8];
        if (kind == 1 || kind == 2) {
#pragma unroll
            for (int bj = 0; bj < 2; ++bj)
#pragma unroll
                for (int i = 0; i < 8; ++i) { const int c = col0 + bj * HALF + i - 512 * kind; const float l0 = lbraw[(kind - 1) * 1024 + c], l1 = lbraw[(kind - 1) * 1024 + 512 + c];
                    om[bj][i] = 1.0f - __builtin_amdgcn_rcpf(1.0f + __builtin_amdgcn_exp2f((l1 - l0) * 1.4426950408889634f)); }
        }
#pragma unroll
        for (int ai = 0; ai < 2; ++ai)
#pragma unroll
            for (int m = 0; m < 4; ++m) { bf16_t* rowp = O + (size_t)(row0 + ai * HALF + m * 16) * ldc + col0;
#pragma unroll
                for (int bj = 0; bj < 2; ++bj) { float v[8] = {acc[ai][bj][m][0][0], acc[ai][bj][m][0][1], acc[ai][bj][m][0][2], acc[ai][bj][m][0][3], acc[ai][bj][m][1][0], acc[ai][bj][m][1][1], acc[ai][bj][m][1][2], acc[ai][bj][m][1][3]};
                    if (kind == 0 || kind == 4) {
#pragma unroll
                        for (int i = 0; i < 8; ++i) v[i] = v[i] * __builtin_amdgcn_rcpf(1.0f + __builtin_amdgcn_exp2f(v[i] * -1.4426950408889634f));
                    } else if (kind == 1 || kind == 2) {
#pragma unroll
                        for (int i = 0; i < 8; ++i) v[i] = om[bj][i] * __builtin_amdgcn_rcpf(1.0f + __builtin_amdgcn_exp2f(v[i] * 1.4426950408889634f));
                    }
                    u32x4 w; w.x = cvt_pk_bf16(v[0], v[1]); w.y = cvt_pk_bf16(v[2], v[3]); w.z = cvt_pk_bf16(v[4], v[5]); w.w = cvt_pk_bf16(v[6], v[7]);
                    *(u32x4*)(rowp + bj * HALF) = w; } }
    }
};
struct GroupedOrder {
    int MT, G, c, NT; const PG8_LAS int* tile_exp;
    __device__ __forceinline__ bool next(int i, Unit& u) const {
        int mt, nt;
        if (G == 256) { const int x = c & 7, slot = c >> 3, GM = 32 / NT; mt = GM * (8 * i + x) + slot / NT; nt = slot % NT; }
        else { const int L = i * G + c; mt = L / NT; nt = L - mt * NT; }
        if (mt >= MT) return false;
        const int ti = tile_exp[mt]; u.pm = mt; u.pn = (ti & 255) * NT + nt; u.ga = (ti & 255) * 16384 + ((ti >> 8) & 255) * 256; u.vr = ((ti >> 16) & 255) + 1; return true; }
    __device__ __forceinline__ void a_ready(const Unit&) const {}
    __device__ __forceinline__ void done(const Unit&) const {}
};
template <class Epi, class Sched, bool ALIGN_EPI = false, bool SP2 = false, bool GATHER = false, bool ROWLIM = false>
__device__ __forceinline__ void gemm_phase(PG8_LAS unsigned char* lds, const Gemm g, const Sched& S, const Epi& E) {
    const int tid = threadIdx.x, wid = __builtin_amdgcn_readfirstlane(tid >> 6), lane = tid & 63, wr = wid >> 2, wc = wid & 3, fr = lane & 15, fq = lane >> 4;
    const int K = g.K, nt = K / BK;
    unsigned voffA[2], voffB[2], cofA[2]; int rowA[2];
#pragma unroll
    for (int i = 0; i < 2; ++i) { int R, C; stage_rc(tid * 16 + i * 8192, R, C); const int Rb = Epi::PERM ? ((R & ~31) + perm32(R & 31)) : R;
        voffA[i] = (unsigned)(R * K + C) * 2u; voffB[i] = (unsigned)(Rb * K + C) * 2u; cofA[i] = (unsigned)C * 2u; rowA[i] = R; }
    const size_t kstep = (size_t)(BK * 2);
    const size_t hstep = (size_t)HALF * K * 2;
    const size_t tstep = 2 * hstep;
    unsigned vAc[2][2], vAn[2][2];
#define PG8_SETA(v, u) do { _Pragma("unroll") for (int h_ = 0; h_ < 2; ++h_) _Pragma("unroll") for (int i_ = 0; i_ < 2; ++i_) { \
        if constexpr (GATHER) { unsigned r_ = (unsigned)g.aidx[(u).ga + h_ * HALF + rowA[i_]]; r_ = r_ < (unsigned)g.amax ? r_ : (unsigned)g.amax; v[h_][i_] = r_ * (unsigned)(K * 2) + cofA[i_]; } else v[h_][i_] = voffA[i_] + (unsigned)(h_ * (int)hstep); } } while (0)
    const unsigned ldsw = (unsigned)wid * 1024u;
    const int aoff = lds_byte(wr * 64 + fr, fq * 8), boff = lds_byte(wc * 32 + fr, fq * 8);
#define PG8_SA(b, h) (((b) * 2 + (h)) * HTB)
#define PG8_SB(b, h) ((4 + (b) * 2 + (h)) * HTB)
#define PG8_STAGE(bufoff, gbase, voff) do { _Pragma("unroll") for (int _i = 0; _i < 2; ++_i) \
        __builtin_amdgcn_global_load_lds((const unsigned*)((const char*)(gbase) + (voff)[_i]), (PG8_LAS unsigned*)(lds + (bufoff) + ldsw + _i * 8192), 16, 0, 0); } while (0)
#define PG8_LDA(dst, b, h) do { _Pragma("unroll") for (int m = 0; m < 4; ++m) _Pragma("unroll") for (int k = 0; k < 2; ++k) dst[m][k] = *(const PG8_LAS bf16x8*)(lds + PG8_SA(b, h) + aoff + m * 2048 + k * 1024); } while (0)
#define PG8_LDB(dst, b, h) do { _Pragma("unroll") for (int n = 0; n < 2; ++n) _Pragma("unroll") for (int k = 0; k < 2; ++k) dst[n][k] = *(const PG8_LAS bf16x8*)(lds + PG8_SB(b, h) + boff + n * 2048 + k * 1024); } while (0)
#define PG8_MMA(ai, bj, At, Bt) do { __builtin_amdgcn_s_setprio(1); _Pragma("unroll") for (int m = 0; m < 4; ++m) _Pragma("unroll") for (int n = 0; n < 2; ++n) _Pragma("unroll") for (int k = 0; k < 2; ++k) \
        acc[ai][bj][m][n] = __builtin_amdgcn_mfma_f32_16x16x32_bf16(Bt[n][k], At[m][k], acc[ai][bj][m][n], 0, 0, 0); __builtin_amdgcn_s_setprio(0); } while (0)
#define PG8_MMAL(ai, bj, At, Bt, lim) do { if constexpr (!ROWLIM) { PG8_MMA(ai, bj, At, Bt); } else { if ((lim) != 0) { PG8_MMA(ai, bj, At, Bt); } } } while (0)
#define PG8_WAIT_V(n) asm volatile("s_waitcnt vmcnt(" #n ")" ::: "memory")
#define PG8_WAIT_L(n) asm volatile("s_waitcnt lgkmcnt(" #n ")" ::: "memory")
#define PG8_BAR __builtin_amdgcn_s_barrier()
#define PG8_SCHED __builtin_amdgcn_sched_barrier(0)
    Unit cur, nxt; int ui = 0;
    if (!S.next(0, cur)) return;
    f32x4 acc[2][2][4][2];
#pragma unroll
    for (int a = 0; a < 2; ++a)
#pragma unroll
        for (int b = 0; b < 2; ++b)
#pragma unroll
            for (int m = 0; m < 4; ++m)
#pragma unroll
                for (int n = 0; n < 2; ++n) acc[a][b][m][n] = (f32x4){0.f, 0.f, 0.f, 0.f};
    bf16x8 At[4][2], B0[2][2], B1[2][2];
    int lim0 = 1, lim1 = 1;
#define PG8_SETLIM(u) do { if constexpr (ROWLIM) { const int r0_ = (u).vr - wr * 64, r1_ = r0_ - HALF; lim0 = r0_ > 0; lim1 = r1_ > 0; } } while (0)
    PG8_SETLIM(cur);
    const char* cA = (const char*)g.A + (GATHER ? (size_t)0 : (size_t)cur.pm * tstep); const char* cB = (const char*)g.Bt + (size_t)cur.pn * tstep;
    PG8_SETA(vAc, cur);
    S.a_ready(cur);
    if constexpr (SP2) {
        PG8_STAGE(PG8_SB(0, 0), cB, voffB); PG8_STAGE(PG8_SB(0, 1), cB + hstep, voffB); PG8_STAGE(PG8_SA(0, 0), cA, vAc[0]); PG8_STAGE(PG8_SA(0, 1), cA, vAc[1]);
        if (wr == 1) PG8_BAR;
        PG8_WAIT_V(2); PG8_BAR;
        PG8_STAGE(PG8_SB(1, 0), cB + kstep, voffB); PG8_STAGE(PG8_SA(1, 0), cA + kstep, vAc[0]); PG8_STAGE(PG8_SB(1, 1), cB + hstep + kstep, voffB);
        PG8_WAIT_V(6); PG8_BAR;
    } else {
        PG8_STAGE(PG8_SB(0, 0), cB, voffB); PG8_STAGE(PG8_SA(0, 0), cA, vAc[0]); PG8_STAGE(PG8_SB(0, 1), cB + hstep, voffB); PG8_STAGE(PG8_SA(0, 1), cA, vAc[1]);
        if (wr == 1) PG8_BAR;
        PG8_WAIT_V(4); PG8_BAR;
        PG8_STAGE(PG8_SB(1, 0), cB + kstep, voffB); PG8_STAGE(PG8_SA(1, 0), cA + kstep, vAc[0]); PG8_STAGE(PG8_SB(1, 1), cB + hstep + kstep, voffB);
        PG8_WAIT_V(6); PG8_BAR;
    }
    for (;;) {
        const bool has_next = S.next(ui + 1, nxt);
        const char* nA = (has_next && !GATHER) ? (const char*)g.A + (size_t)nxt.pm * tstep : cA; const char* nB = has_next ? (const char*)g.Bt + (size_t)nxt.pn * tstep : cB;
        if (has_next) PG8_SETA(vAn, nxt); else { vAn[0][0] = vAc[0][0]; vAn[0][1] = vAc[0][1]; vAn[1][0] = vAc[1][0]; vAn[1][1] = vAc[1][1]; }
        for (int t = 0; t < nt; t += 2) {
            const bool last = (t == nt - 2);
            const char* a1 = cA + (size_t)(t + 1) * kstep;
            const char* a2 = last ? nA : cA + (size_t)(t + 2) * kstep; const char* b2 = last ? nB : cB + (size_t)(t + 2) * kstep;
            const char* a3 = a2 + kstep; const char* b3 = b2 + kstep;
            unsigned vS0[2] = {vAc[0][0], vAc[0][1]}, vS1[2] = {vAc[1][0], vAc[1][1]};
            if (last) { asm volatile("" ::: "memory"); vS0[0] = vAn[0][0]; vS0[1] = vAn[0][1]; vS1[0] = vAn[1][0]; vS1[1] = vAn[1][1]; }
            if (last && has_next) S.a_ready(nxt);
            if constexpr (SP2) {
            PG8_LDB(B0, 0, 0); PG8_LDB(B1, 0, 1); PG8_SCHED; PG8_LDA(At, 0, 0); PG8_STAGE(PG8_SA(1, 1), a1, vAc[1]);
            PG8_WAIT_V(8); PG8_WAIT_L(0); PG8_BAR; PG8_MMAL(0, 0, At, B0, lim0); PG8_MMAL(0, 1, At, B1, lim0); PG8_BAR; PG8_SCHED;
            PG8_LDA(At, 0, 1); PG8_STAGE(PG8_SB(0, 0), b2, voffB); PG8_STAGE(PG8_SB(0, 1), b2 + hstep, voffB); PG8_STAGE(PG8_SA(0, 0), a2, vS0);
            PG8_WAIT_V(8); PG8_WAIT_L(0); PG8_BAR; PG8_MMAL(1, 0, At, B0, lim1); PG8_MMAL(1, 1, At, B1, lim1); PG8_BAR; PG8_SCHED;
            PG8_LDB(B0, 1, 0); PG8_LDB(B1, 1, 1); PG8_SCHED; PG8_LDA(At, 1, 0); PG8_STAGE(PG8_SA(0, 1), a2, vS1);
            PG8_WAIT_V(8); PG8_WAIT_L(0); PG8_BAR; PG8_MMAL(0, 0, At, B0, lim0); PG8_MMAL(0, 1, At, B1, lim0); PG8_BAR; PG8_SCHED;
            PG8_LDA(At, 1, 1); PG8_STAGE(PG8_SB(1, 0), b3, voffB); PG8_STAGE(PG8_SB(1, 1), b3 + hstep, voffB); PG8_STAGE(PG8_SA(1, 0), a3, vS0);
            PG8_WAIT_V(8); PG8_WAIT_L(0); PG8_BAR; PG8_MMAL(1, 0, At, B0, lim1); PG8_MMAL(1, 1, At, B1, lim1); PG8_BAR; PG8_SCHED;
            } else {
            PG8_LDB(B0, 0, 0); PG8_SCHED; PG8_LDA(At, 0, 0); PG8_STAGE(PG8_SA(1, 1), a1, vAc[1]);
            PG8_WAIT_L(8); PG8_BAR; PG8_WAIT_L(0); PG8_MMA(0, 0, At, B0); PG8_BAR; PG8_SCHED;
            PG8_LDB(B1, 0, 1); PG8_STAGE(PG8_SB(0, 0), b2, voffB);
            PG8_BAR; PG8_WAIT_L(0); PG8_MMA(0, 1, At, B1); PG8_BAR;
            PG8_LDA(At, 0, 1); PG8_STAGE(PG8_SA(0, 0), a2, vS0);
            PG8_BAR; PG8_WAIT_L(0); PG8_MMA(1, 0, At, B0); PG8_BAR; PG8_SCHED;
            PG8_STAGE(PG8_SB(0, 1), b2 + hstep, voffB);
            PG8_WAIT_V(6); PG8_BAR; PG8_MMA(1, 1, At, B1); PG8_BAR;
            PG8_LDB(B0, 1, 0); PG8_SCHED; PG8_LDA(At, 1, 0); PG8_STAGE(PG8_SA(0, 1), a2, vS1);
            PG8_WAIT_L(8); PG8_BAR; PG8_WAIT_L(0); PG8_MMA(0, 0, At, B0); PG8_BAR; PG8_SCHED;
            PG8_LDB(B1, 1, 1); PG8_STAGE(PG8_SB(1, 0), b3, voffB);
            PG8_BAR; PG8_WAIT_L(0); PG8_MMA(0, 1, At, B1); PG8_BAR;
            PG8_LDA(At, 1, 1); PG8_STAGE(PG8_SA(1, 0), a3, vS0);
            PG8_BAR; PG8_WAIT_L(0); PG8_MMA(1, 0, At, B0); PG8_BAR; PG8_SCHED;
            PG8_STAGE(PG8_SB(1, 1), b3 + hstep, voffB);
            PG8_WAIT_V(6); PG8_BAR; PG8_MMA(1, 1, At, B1); PG8_BAR;
            }
        }
        if constexpr (ALIGN_EPI) { if (wr == 0) PG8_BAR; }
        if constexpr (!Epi::AFTER_DRAIN) { E(acc, cur, wr, wc, fr, fq); S.done(cur); }
        if (!has_next) break;
#pragma unroll
        for (int a = 0; a < 2; ++a)
#pragma unroll
            for (int b = 0; b < 2; ++b)
#pragma unroll
                for (int m = 0; m < 4; ++m)
#pragma unroll
                    for (int n = 0; n < 2; ++n) acc[a][b][m][n] = (f32x4){0.f, 0.f, 0.f, 0.f};
        cur = nxt; cA = nA; cB = nB; ++ui; PG8_SETLIM(cur); vAc[0][0] = vAn[0][0]; vAc[0][1] = vAn[0][1]; vAc[1][0] = vAn[1][0]; vAc[1][1] = vAn[1][1];
        if constexpr (ALIGN_EPI) { if (wr == 1) PG8_BAR; }
    }
    PG8_WAIT_V(0);
    if constexpr (!ALIGN_EPI) { if (wr == 0) PG8_BAR; }
    PG8_BAR;
    if constexpr (Epi::AFTER_DRAIN) { E.fused(acc, cur, wr, wc, fr, fq, lds, wid, lane); S.done(cur); }
#undef PG8_SA
#undef PG8_SB
#undef PG8_STAGE
#undef PG8_LDA
#undef PG8_LDB
#undef PG8_MMA
#undef PG8_MMAL
#undef PG8_SETLIM
#undef PG8_WAIT_V
#undef PG8_WAIT_L
#undef PG8_BAR
#undef PG8_SCHED
#undef PG8_SETA
}
}
#define GAS __attribute__((address_space(1)))
#define LAS __attribute__((address_space(3)))
typedef unsigned short bf16;
typedef unsigned v4u __attribute__((ext_vector_type(4)));
typedef float f32x4 __attribute__((ext_vector_type(4)));
typedef short bf16x8 __attribute__((ext_vector_type(8)));
typedef GAS unsigned gu32;
typedef GAS unsigned long long gu64;
#define RLX_AGENT __ATOMIC_RELAXED, __HIP_MEMORY_SCOPE_AGENT
#define LDS_WAIT() asm volatile("s_waitcnt lgkmcnt(0)" ::: "memory")
#define VM_WAIT() asm volatile("s_waitcnt vmcnt(0)" ::: "memory")
__device__ __forceinline__ unsigned long long rt() { return __builtin_amdgcn_s_memrealtime(); }
__device__ __forceinline__ unsigned f2bf(float f) { unsigned u = __builtin_bit_cast(unsigned, f); return (u + 0x7fffu + ((u >> 16) & 1u)) >> 16; }
__device__ __forceinline__ unsigned pk2(float lo, float hi) { return f2bf(lo) | (f2bf(hi) << 16); }

#define XB_TMO      128
#define XB_XCNT(j)  (256  + 64 * (j))
#define XB_XSUB(j)  (1280 + 64 * (j))
#define XB_XGEN(j)  (2304 + 64 * (j))
#define XB_TOP      3328
#define XB_TOPGEN   3392
#define XCD_BAR_WORDS 3456
#define XB_SPIN_CAP (1u << 18)

__device__ __forceinline__ unsigned xb_ld(unsigned* p)              { return __hip_atomic_load(p, __ATOMIC_RELAXED, __HIP_MEMORY_SCOPE_AGENT); }
__device__ __forceinline__ unsigned xb_add(unsigned* p, unsigned v) { return __hip_atomic_fetch_add(p, v, __ATOMIC_RELAXED, __HIP_MEMORY_SCOPE_AGENT); }
__device__ __forceinline__ unsigned xb_xcc_id() { return (unsigned)__builtin_amdgcn_s_getreg((3 << 11) | 20) & 0xFu; }
#define XB_SPIN(cond, bar) do { unsigned _sp = 0; while (cond) { __builtin_amdgcn_s_sleep(1); \
    if ((++_sp & 255u) == 0u) { if (xb_ld(&(bar)[XB_TMO])) break; if (_sp > XB_SPIN_CAP) { atomicAdd(&(bar)[XB_TMO], 1u); break; } } } } while (0)

struct XcdBarrier {
    unsigned* bar; unsigned x;
    volatile LAS unsigned* st;
};

__device__ __forceinline__ XcdBarrier xcd_barrier_post(unsigned* bar, volatile LAS unsigned* st) {
    XcdBarrier b; b.bar = bar; b.x = xb_xcc_id(); b.st = st;
    if (threadIdx.x == 0) (void)xb_add(&bar[XB_XCNT(b.x)], 1u);
    return b;
}
__device__ __forceinline__ void xcd_barrier_complete(unsigned* bar, unsigned x, unsigned& nloc, unsigned& nx) {
    const unsigned G = gridDim.x * gridDim.y * gridDim.z;
    unsigned sum, cnt, mine, sp = 0u;
    for (;;) {
        sum = 0u; cnt = 0u; mine = 0u;
#pragma unroll
        for (unsigned j = 0; j < 16; ++j) { const unsigned c = xb_ld(&bar[XB_XCNT(j)]); sum += c; cnt += (c > 0u) ? 1u : 0u; mine = (j == x) ? c : mine; }
        if (sum == G) break;
        __builtin_amdgcn_s_sleep(1);
        if ((++sp & 255u) == 0u) { if (xb_ld(&bar[XB_TMO])) break; if (sp > XB_SPIN_CAP) { atomicAdd(&bar[XB_TMO], 1u); break; } }
    }
    nloc = mine > 0u ? mine : 1u; nx = cnt > 0u ? cnt : 1u;
}

__device__ __forceinline__ void xcd_barrier(const XcdBarrier& b) {
    asm volatile("s_waitcnt vmcnt(0)" ::: "memory");
    __syncthreads();
    if (threadIdx.x == 0) {
        unsigned* bar = b.bar;
        __builtin_amdgcn_s_waitcnt(0);
        unsigned nloc = b.st[0], nx = b.st[1];
        if (nloc == 0u) { xcd_barrier_complete(bar, b.x, nloc, nx); b.st[0] = nloc; b.st[1] = nx; }
        const unsigned old = xb_add(&bar[XB_XSUB(b.x)], 1u);
        const unsigned gen = old / nloc;
        if (old + 1u == (gen + 1u) * nloc) {
            __builtin_amdgcn_fence(__ATOMIC_RELEASE, "agent");
            asm volatile("s_waitcnt vmcnt(0)" ::: "memory");
            const unsigned og = xb_add(&bar[XB_TOP], 1u);
            const unsigned tg = og / nx;
            if (og + 1u == (tg + 1u) * nx) xb_add(&bar[XB_TOPGEN], 1u);
            else XB_SPIN(xb_ld(&bar[XB_TOPGEN]) == tg, bar);
            __builtin_amdgcn_fence(__ATOMIC_ACQUIRE, "agent");
            xb_add(&bar[XB_XGEN(b.x)], 1u);
            asm volatile("s_waitcnt vmcnt(0)" ::: "memory");
        } else {
            XB_SPIN(xb_ld(&bar[XB_XGEN(b.x)]) == gen, bar);
            __builtin_amdgcn_fence(__ATOMIC_ACQUIRE, "agent");
            asm volatile("s_waitcnt vmcnt(0)" ::: "memory");
        }
    }
    __syncthreads();
}
constexpr int NB = 8, SEQ = 2048, DM = 1024, MTOK = NB * SEQ;
constexpr int PCOLS = 4608;
constexpr int A_COLS = 2560, B_COLS = 1856;
constexpr int NEXP = 32, ROWS_PAD = 73728;
constexpr float LOG2E = 1.4426950408889634f;
constexpr float QSCALE = 0.125f * LOG2E;
constexpr float LAM_INIT = 0.35550906759096926f;

constexpr size_t MiB = 1u << 20;
constexpr size_t WS_CTL = 0, CTL_ZERO_BYTES = 1 * MiB;
constexpr size_t WS_MODP = 2 * MiB, WS_MOD = 5 * MiB, WS_BIAS = 6 * MiB;
constexpr size_t WS_WAB = 8 * MiB, WS_WOUT = 17 * MiB, WS_WQKV = 19 * MiB, WS_WAO = 25 * MiB, WS_LWT = 27 * MiB;
constexpr size_t WS_W1T = 32 * MiB, WS_W2T = 288 * MiB;
constexpr size_t WS_H = 416 * MiB, WS_P = 448 * MiB, WS_XA = 592 * MiB, WS_XB = 656 * MiB, WS_YMIX = 720 * MiB;
constexpr size_t WS_HS = 752 * MiB, WS_ACT = 896 * MiB, WS_EO = 1040 * MiB;
constexpr size_t WS_REC = 1184 * MiB, WS_RY = 1408 * MiB, WS_RG = 1472 * MiB, WS_RBON = 1504 * MiB, WS_HO = 1506 * MiB;
constexpr size_t WS_ROUTE = 1570 * MiB, WS_END = 1574 * MiB;
constexpr size_t WS_SIDXS = WS_HS;
constexpr size_t RT_E = 0, RT_W = 256 * 1024, RT_RANK = 512 * 1024, RT_POS = 768 * 1024, RT_GATE = 1024 * 1024, RT_SIDX = 1536 * 1024;
constexpr int CW_CNT = 64;
constexpr int CW_BAR = 4096;
constexpr int SCR_BYTES = 139264;
constexpr int LDSCTL_OFF = SCR_BYTES;
constexpr int LDS_BYTES = SCR_BYTES + 16384;

typedef float f32x16 __attribute__((ext_vector_type(16)));
typedef short s16x4 __attribute__((ext_vector_type(4)));
typedef unsigned u32x2 __attribute__((ext_vector_type(2)));

struct Ptrs {
    const float* in[33]; float* out; unsigned char* ws;
};

__device__ __forceinline__ float bf2f(unsigned short b) { return __uint_as_float((unsigned)b << 16); }
__device__ __forceinline__ float bflo(unsigned w) { return __uint_as_float(w << 16); }
__device__ __forceinline__ float bfhi(unsigned w) { return __uint_as_float(w & 0xffff0000u); }
template <int CTRL> __device__ __forceinline__ float dpp_f(float x) { return __int_as_float(__builtin_amdgcn_update_dpp(0, __float_as_int(x), CTRL, 0xF, 0xF, true)); }
__device__ __forceinline__ float xor16_f(float x) { return __int_as_float(__builtin_amdgcn_ds_swizzle(__float_as_int(x), 0x401F)); }
__device__ __forceinline__ float sum_halves(float x) {
    const auto rr = __builtin_amdgcn_permlane32_swap(__float_as_uint(x), __float_as_uint(x), false, false); return __uint_as_float(rr[0]) + __uint_as_float(rr[1]); }
__device__ __forceinline__ float sum16(float x) {
    x += dpp_f<0xB1>(x); x += dpp_f<0x4E>(x); x += dpp_f<0x141>(x); x += dpp_f<0x140>(x); return x;
}
__device__ __forceinline__ float wave_sum(float v) { v = sum16(v); v += xor16_f(v); return sum_halves(v); }
__device__ __forceinline__ float sum8(float x) {
    x += dpp_f<0xB1>(x); x += dpp_f<0x4E>(x); x += dpp_f<0x141>(x); return x;
}
__device__ __forceinline__ float sigmoidf_(float x) { return __builtin_amdgcn_rcpf(1.0f + __builtin_amdgcn_exp2f(-LOG2E * x)); }
__device__ __forceinline__ float expf_(float x) { return __builtin_amdgcn_exp2f(LOG2E * x); }
__device__ __forceinline__ bf16x8 pack8(float a0, float a1, float a2, float a3, float a4, float a5, float a6, float a7) {
    v4u w; w.x = pg8::cvt_pk_bf16(a0, a1); w.y = pg8::cvt_pk_bf16(a2, a3); w.z = pg8::cvt_pk_bf16(a4, a5); w.w = pg8::cvt_pk_bf16(a6, a7);
    return __builtin_bit_cast(bf16x8, w);
}
__device__ __forceinline__ int crow(int r, int hi) { return (r & 3) + 8 * (r >> 2) + 4 * hi; }

struct TrDesc { const float* W; bf16* WT; int K, N, kb, nb; };
__device__ __forceinline__ void tr_issue(const TrDesc& d, f32x4 (&v)[16], int lane) {
    const float* src = d.W + (size_t)(d.kb * 64 + (lane >> 4)) * d.N + d.nb * 64 + (lane & 15) * 4;
#pragma unroll
    for (int i = 0; i < 16; ++i) v[i] = *(const f32x4*)(src + (size_t)(4 * i) * d.N);
}
constexpr int TR_PITCH = 72;
__device__ __forceinline__ void tr_finish(const TrDesc& d, const f32x4 (&v)[16], LAS float* scr, int lane) {
    LAS bf16* img = (LAS bf16*)scr;
#pragma unroll
    for (int i = 0; i < 16; ++i) { u32x2 w; w.x = pg8::cvt_pk_bf16(v[i].x, v[i].y); w.y = pg8::cvt_pk_bf16(v[i].z, v[i].w);
        *(LAS u32x2*)(img + (4 * i + (lane >> 4)) * TR_PITCH + (lane & 15) * 4) = w; }
    LDS_WAIT(); asm volatile("" ::: "memory");
    typedef short v4i16_t __attribute__((ext_vector_type(4)));
    const int g = lane >> 4, li = lane & 15;
    const LAS bf16* rbase = img + (8 * g + (li >> 2)) * TR_PITCH + 4 * (li & 3);
#pragma unroll
    for (int kh = 0; kh < 2; ++kh)
#pragma unroll
        for (int cb = 0; cb < 4; ++cb) {
            const LAS bf16* p = rbase + (32 * kh) * TR_PITCH + 16 * cb;
            const s16x4 lo = __builtin_bit_cast(s16x4, __builtin_amdgcn_ds_read_tr16_b64_v4i16((LAS v4i16_t*)p));
            const s16x4 hi = __builtin_bit_cast(s16x4, __builtin_amdgcn_ds_read_tr16_b64_v4i16((LAS v4i16_t*)(p + 4 * TR_PITCH)));
            const bf16x8 o = (bf16x8){lo[0], lo[1], lo[2], lo[3], hi[0], hi[1], hi[2], hi[3]};
            *(bf16x8*)(d.WT + (size_t)(d.nb * 64 + 16 * cb + li) * d.K + d.kb * 64 + 32 * kh + 8 * g) = o; }
    LDS_WAIT(); asm volatile("" ::: "memory");
}
__device__ __forceinline__ void tr_item(const float* __restrict__ W, int K, int N, bf16* __restrict__ WT, LAS float* scr, int kb, int nb, int lane) {
    TrDesc d; d.W = W; d.WT = WT; d.K = K; d.N = N; d.kb = kb; d.nb = nb; f32x4 v[16]; tr_issue(d, v, lane); tr_finish(d, v, scr, lane);
}
constexpr int TRD_I1 = 256, TRD_I2 = 16 * 48, TRD_I3 = 256, TRD_I4 = 64 * 512, TRD_I5 = 64 * 256, TRD_N = TRD_I1 + TRD_I2 + TRD_I3 + TRD_I4 + TRD_I5;
__device__ __forceinline__ TrDesc tr_decode(const Ptrs& P, int it) {
    unsigned char* ws = P.ws; int r = it; TrDesc d;
    if (r < TRD_I1) { d.W = P.in[13]; d.WT = (bf16*)(ws + WS_WOUT); d.K = 1024; d.N = 1024; d.kb = r >> 4; d.nb = r & 15; return d; } r -= TRD_I1;
    if (r < TRD_I2) { d.W = P.in[27]; d.WT = (bf16*)(ws + WS_WQKV); d.K = 1024; d.N = 3072; d.kb = r / 48; d.nb = r % 48; return d; } r -= TRD_I2;
    if (r < TRD_I3) { d.W = P.in[28]; d.WT = (bf16*)(ws + WS_WAO); d.K = 1024; d.N = 1024; d.kb = r >> 4; d.nb = r & 15; return d; } r -= TRD_I3;
    if (r < TRD_I4) { const int mat = r >> 9, q = r & 511; d.W = P.in[8] + (size_t)mat * 1024 * 2048; d.WT = (bf16*)(ws + WS_W1T) + (size_t)mat * 2048 * 1024; d.K = 1024; d.N = 2048; d.kb = q >> 5; d.nb = q & 31; return d; } r -= TRD_I4;
    { const int mat = r >> 8, q = r & 255; d.W = P.in[10] + (size_t)mat * 1024 * 1024; d.WT = (bf16*)(ws + WS_W2T) + (size_t)mat * 1024 * 1024; d.K = 1024; d.N = 1024; d.kb = q >> 4; d.nb = q & 15; return d; }
}

__device__ __forceinline__ void p0_prologue(const Ptrs& P, LAS unsigned char* lds, int tid, int lane, int wave, int blk, int G) {
    unsigned char* ws = P.ws;
    LAS float* ldsf = (LAS float*)lds;
    for (int i = tid; i < NB * DM; i += 512) { const int b = i >> 10, k = i & 1023; const float c = P.in[1][i]; ldsf[k * 8 + b] = c * sigmoidf_(c); }
    __syncthreads();
    {
        float* modp = (float*)(ws + WS_MODP);
        const int gw = blk * 8 + wave, NGW = G * 8;
        for (int task = gw; task < 1536; task += NGW) {
            const int kc = task & 7, cg = (task >> 3) % 96, l = task / 768;
            const int n = cg * 64 + lane;
            const float* w = P.in[2] + ((size_t)l * 1024 + kc * 128) * 6144 + n;
            float acc[8];
#pragma unroll
            for (int b = 0; b < 8; ++b) acc[b] = 0.f;
#pragma unroll 8
            for (int k = 0; k < 128; ++k) {
                const float wv = w[(size_t)k * 6144];
                const f32x4 c0 = *(const LAS f32x4*)(ldsf + (kc * 128 + k) * 8), c1 = *(const LAS f32x4*)(ldsf + (kc * 128 + k) * 8 + 4);
                acc[0] += c0.x * wv; acc[1] += c0.y * wv; acc[2] += c0.z * wv; acc[3] += c0.w * wv;
                acc[4] += c1.x * wv; acc[5] += c1.y * wv; acc[6] += c1.z * wv; acc[7] += c1.w * wv;
            }
#pragma unroll
            for (int b = 0; b < 8; ++b) modp[((size_t)(kc * 2 + l) * 8 + b) * 6144 + n] = acc[b];
        }
    }
    {
        float* biasT = (float*)(ws + WS_BIAS);
        for (int idx = blk * 512 + tid; idx < 8 * 4096; idx += G * 512) {
            const int h = idx >> 12, i = idx & 4095;
            if (i < 4095) {
                const int rel = i - 2047, n = rel < 0 ? -rel : rel;
                int bk = n < 8 ? n : n < 12 ? 8 : n < 16 ? 9 : n < 23 ? 10 : n < 32 ? 11 : n < 46 ? 12 : n < 64 ? 13 : n < 91 ? 14 : 15;
                if (rel > 0) bk += 16;
                biasT[idx] = P.in[31][bk * 8 + h] * LOG2E;
            }
        }
    }
    {
        bf16* LWT = (bf16*)(ws + WS_LWT);
        for (int idx = blk * 512 + tid; idx < 512 * 320; idx += G * 512) {
            const int l = idx >> 9, c = idx & 511;
            const float v = l < 128 ? P.in[18][l * 512 + c] : l < 192 ? P.in[20][(l - 128) * 512 + c] : P.in[21][(l - 192) * 512 + c];
            LWT[c * 320 + l] = (bf16)(pg8::cvt_pk_bf16(v, 0.f) & 0xffffu);
        }
    }
    {
        v4u* z = (v4u*)(ws + WS_WAB + (size_t)4416 * 1024 * 2);
        for (int i = blk * 512 + tid; i < 192 * 1024 * 2 / 16; i += G * 512) z[i] = (v4u){0u, 0u, 0u, 0u};
    }
    __syncthreads();
    {
        LAS float* scr = (LAS float*)(lds + wave * 16640);
        const int gw = blk * 8 + wave, NGW = G * 8;
        constexpr int I0 = 16 * 69;
        for (int it = gw; it < I0; it += NGW) tr_item(P.in[12], 1024, 4416, (bf16*)(ws + WS_WAB), scr, it / 69, it % 69, lane);
    }
}

template <bool FROM_PART>
__device__ __forceinline__ void load_mod_vec(const Ptrs& P, LAS float* eg, LAS float* sh, const float* gain, int l, int b, int which_shift, int tid) {
    const float* modp = (const float*)(P.ws + WS_MODP); const float* mod = (const float*)(P.ws + WS_MOD);
    for (int k = tid; k < 1024; k += 512) {
        float s, c;
        if (FROM_PART) {
            s = P.in[3][l * 6144 + which_shift * 1024 + k]; c = P.in[3][l * 6144 + (which_shift + 1) * 1024 + k];
#pragma unroll
            for (int kc = 0; kc < 8; ++kc) { s += modp[((size_t)(kc * 2 + l) * 8 + b) * 6144 + which_shift * 1024 + k]; c += modp[((size_t)(kc * 2 + l) * 8 + b) * 6144 + (which_shift + 1) * 1024 + k]; }
        } else { s = mod[((size_t)l * 8 + b) * 6144 + which_shift * 1024 + k]; c = mod[((size_t)l * 8 + b) * 6144 + (which_shift + 1) * 1024 + k]; }
        eg[k] = gain[k] * (1.0f + c); sh[k] = s;
    }
}
__device__ __forceinline__ void ld_row_bf16(const bf16* row, f32x4 (&v)[4], int lane) {
#pragma unroll
    for (int j = 0; j < 4; ++j) { const u32x2 w = *(const u32x2*)(row + 4 * lane + 256 * j); v[j] = (f32x4){bflo(w.x), bfhi(w.x), bflo(w.y), bfhi(w.y)}; }
}
__device__ __forceinline__ void st_row_bf16(bf16* row, const f32x4 (&v)[4], int lane) {
#pragma unroll
    for (int j = 0; j < 4; ++j) { u32x2 w; w.x = pg8::cvt_pk_bf16(v[j].x, v[j].y); w.y = pg8::cvt_pk_bf16(v[j].z, v[j].w); *(u32x2*)(row + 4 * lane + 256 * j) = w; }
}
__device__ __forceinline__ float row_rstd(const f32x4 (&v)[4]) {
    float s = 0.f;
#pragma unroll
    for (int j = 0; j < 4; ++j) s += (v[j].x * v[j].x + v[j].y * v[j].y) + (v[j].z * v[j].z + v[j].w * v[j].w);
    return 1.0f / sqrtf(wave_sum(s) * (1.0f / 1024.0f) + 1e-6f);
}
__device__ __forceinline__ void store_h_row(bf16* hrow, const f32x4 (&v)[4], float rstd, const LAS float* eg, const LAS float* sh, int lane) {
#pragma unroll
    for (int j = 0; j < 4; ++j) { const int k = 4 * lane + 256 * j; const f32x4 g = *(const LAS f32x4*)(eg + k), s = *(const LAS f32x4*)(sh + k);
        u32x2 w; w.x = pg8::cvt_pk_bf16(v[j].x * rstd * g.x + s.x, v[j].y * rstd * g.y + s.y); w.y = pg8::cvt_pk_bf16(v[j].z * rstd * g.z + s.z, v[j].w * rstd * g.w + s.w);
        *(u32x2*)(hrow + k) = w; }
}
__device__ __forceinline__ void p1_norm0(const Ptrs& P, LAS unsigned char* lds, int tid, int lane, int wave, int blk, int G) {
    LAS float* eg = (LAS float*)lds; LAS float* sh = eg + 1024;
    {
        const float* modp = (const float*)(P.ws + WS_MODP); float* mod = (float*)(P.ws + WS_MOD);
        for (int i = blk * 512 + tid; i < 2 * 8 * 6144; i += G * 512) { const int n = i % 6144, lb = i / 6144, l = lb >> 3, b = lb & 7; float s = P.in[3][l * 6144 + n];
#pragma unroll
            for (int kc = 0; kc < 8; ++kc) s += modp[((size_t)(kc * 2 + l) * 8 + b) * 6144 + n];
            mod[i] = s; }
    }
    bf16* H = (bf16*)(P.ws + WS_H);
    for (int rb = blk; rb < 256; rb += G) {
        const int b = rb >> 5;
        __syncthreads();
        load_mod_vec<true>(P, eg, sh, P.in[4], 0, b, 0, tid);
        __syncthreads();
#pragma unroll 4
        for (int i = 0; i < 8; ++i) { const int m = rb * 64 + wave * 8 + i; const f32x4* xr = (const f32x4*)(P.in[0] + (size_t)m * 1024) + lane;
            f32x4 v[4];
#pragma unroll
            for (int j = 0; j < 4; ++j) v[j] = xr[64 * j];
            const float rstd = row_rstd(v); store_h_row(H + (size_t)m * 1024, v, rstd, eg, sh, lane); }
    }
}
constexpr int P3_ACTP = 328;
__device__ __forceinline__ float sum32h(float x) {
    x = sum16(x); x += xor16_f(x); return x;
}
__device__ __forceinline__ float tanhf_(float x) { return 1.0f - 2.0f * __builtin_amdgcn_rcpf(1.0f + __builtin_amdgcn_exp2f(2.0f * LOG2E * x)); }
__device__ __forceinline__ void p3_rwkv_prep(const Ptrs& P, LAS unsigned char* lds, int tid, int lane, int wave, int first, int stride) {
    LAS bf16* Rl = (LAS bf16*)lds;
    LAS bf16* Kl = Rl + 32 * 512;
    LAS bf16* Vl = Kl + 32 * 512;
    LAS bf16* ACT = Vl + 32 * 512;
    const bf16* Pb = (const bf16*)(P.ws + WS_P);
    const bf16* LWT = (const bf16*)(P.ws + WS_LWT);
    float* REC = (float*)(P.ws + WS_REC); float* RBON = (float*)(P.ws + WS_RBON);
    unsigned* RG = (unsigned*)(P.ws + WS_RG);
    const float* mu = P.in[16]; const float* w0 = P.in[17]; const float* a0 = P.in[19];
    const float* k_k = P.in[22]; const float* k_a = P.in[23]; const float* r_k = P.in[24];
    const int h = wave, r32 = lane & 31, hi = lane >> 5;
    float w0f[2], w0b[2], a0c[2], kkc[2], kac[2], rkc[2];
#pragma unroll
    for (int ct = 0; ct < 2; ++ct) { const int c = 64 * h + 32 * ct + r32; w0f[ct] = w0[c]; w0b[ct] = w0[512 + c]; a0c[ct] = a0[c]; kkc[ct] = k_k[c]; kac[ct] = k_a[c]; rkc[ct] = r_k[c]; }
    for (int tile = first; tile < MTOK / 32; tile += stride) {
        const int m0 = tile * 32, t0 = m0 & 2047, b = m0 >> 11;
        __syncthreads();
        for (int cp = tid; cp < B_COLS / 2; cp += 512) {
            const int col = 2 * cp;
            const unsigned* src = (const unsigned*)(Pb + (size_t)m0 * PCOLS + A_COLS + col);
            unsigned w[34];
#pragma unroll
            for (int j = 0; j < 34; ++j) { const int t = t0 - 1 + j; w[j] = (t >= 0 && t < 2048) ? src[(ptrdiff_t)(j - 1) * (PCOLS / 2)] : 0u; }
            const float mu0 = mu[col], mu1 = mu[col + 1];
            LAS unsigned* dst; int kind;
            if (col < 512) { dst = (LAS unsigned*)(Rl + col); kind = 0; }
            else if (col < 1024) { dst = (LAS unsigned*)(Kl + col - 512); kind = 0; }
            else if (col < 1536) { dst = (LAS unsigned*)(Vl + col - 1024); kind = 0; }
            else if (col < 1664) { dst = (LAS unsigned*)(ACT + col - 1536); kind = 1; }
            else if (col < 1728) { dst = (LAS unsigned*)(ACT + col - 1536); kind = 2; }
            else { dst = (LAS unsigned*)(ACT + col - 1536); kind = 3; }
            const int pitchw = (kind == 0) ? 256 : (P3_ACTP / 2);
#pragma unroll
            for (int j = 0; j < 32; ++j) {
                const float p0 = bflo(w[j + 1]), p1 = bfhi(w[j + 1]);
                float v0 = p0 + mu0 * (0.5f * (bflo(w[j]) + bflo(w[j + 2])) - p0), v1 = p1 + mu1 * (0.5f * (bfhi(w[j]) + bfhi(w[j + 2])) - p1);
                if (kind == 1) { v0 = tanhf_(v0); v1 = tanhf_(v1); } else if (kind == 3) { v0 = sigmoidf_(v0); v1 = sigmoidf_(v1); }
                dst[j * pitchw] = pg8::cvt_pk_bf16(v0, v1);
            }
        }
        __syncthreads();
        f32x16 acc[4][2];
#pragma unroll
        for (int mt = 0; mt < 4; ++mt)
#pragma unroll
            for (int ct = 0; ct < 2; ++ct)
#pragma unroll
                for (int r = 0; r < 16; ++r) acc[mt][ct][r] = 0.f;
#pragma unroll
        for (int mt = 0; mt < 4; ++mt) {
            const int lbase = mt * 64, nks = (mt == 3) ? 8 : 4;
#pragma unroll
            for (int ks = 0; ks < 8; ++ks) {
                if (ks < nks) {
                    const bf16x8 a = *(const LAS bf16x8*)(ACT + r32 * P3_ACTP + lbase + 16 * ks + 8 * hi);
#pragma unroll
                    for (int ct = 0; ct < 2; ++ct) {
                        const bf16x8 bw = *(const bf16x8*)(LWT + (size_t)(64 * h + 32 * ct + r32) * 320 + lbase + 16 * ks + 8 * hi);
                        acc[mt][ct] = __builtin_amdgcn_mfma_f32_32x32x16_bf16(a, bw, acc[mt][ct], 0, 0, 0);
                    }
                }
            }
        }
#pragma unroll
        for (int r = 0; r < 16; ++r) {
            const int j = crow(r, hi), m = m0 + j, t = t0 + j;
            float df[2], db[2], kp[2], kkr[2], av[2], rr[2], vv[2];
            float ss = 0.f, bon = 0.f;
#pragma unroll
            for (int ct = 0; ct < 2; ++ct) {
                const int c = 64 * h + 32 * ct + r32;
                const float zf = -(w0f[ct] + acc[0][ct][r]), zb = -(w0b[ct] + acc[1][ct][r]);
                const float spf = fmaxf(zf, 0.f) + __logf(1.0f + expf_(-fabsf(zf))), spb = fmaxf(zb, 0.f) + __logf(1.0f + expf_(-fabsf(zb)));
                df[ct] = expf_(-expf_(-spf - 0.5f)); db[ct] = expf_(-expf_(-spb - 0.5f));
                av[ct] = sigmoidf_(a0c[ct] + acc[2][ct][r]);
                const float kraw = bf2f(Kl[j * 512 + c]); rr[ct] = bf2f(Rl[j * 512 + c]); vv[ct] = bf2f(Vl[j * 512 + c]);
                kkr[ct] = kraw * kkc[ct]; kp[ct] = kraw * (1.0f + (av[ct] - 1.0f) * kac[ct]);
                ss += kkr[ct] * kkr[ct]; bon += rr[ct] * kp[ct] * rkc[ct];
            }
            ss = sum32h(ss); bon = sum32h(bon);
            const float rn = 1.0f / fmaxf(sqrtf(ss), 1e-12f);
#pragma unroll
            for (int ct = 0; ct < 2; ++ct) {
                const float kk = kkr[ct] * rn;
                float* rec = REC + ((size_t)(b * 8 + h) * 2048 + t) * 448 + 32 * ct + r32;
                rec[0] = df[ct]; rec[64] = db[ct]; rec[128] = kp[ct]; rec[192] = kk; rec[256] = kk * av[ct]; rec[320] = rr[ct]; rec[384] = vv[ct];
            }
            RG[(size_t)m * 256 + 32 * h + r32] = pg8::cvt_pk_bf16(acc[3][0][r], acc[3][1][r]);
            if (r32 == 0) RBON[(size_t)m * 8 + h] = bon;
        }
    }
}

constexpr int RS_CS = 16, RS_NCH = 2048 / RS_CS;
constexpr int RS_BUF_BYTES = 2 * RS_CS * 384 * 4, RS_Y_BYTES = 2 * RS_CS * 32 * 4, RS_CONV_OFF = RS_BUF_BYTES + RS_Y_BYTES;
static_assert(RS_CONV_OFF + 4 * 16640 <= SCR_BYTES, "scan LDS");
__device__ __forceinline__ void rwkv_scan_unit(const Ptrs& P, LAS unsigned char* lds, int unit, int tid, int lane, int wave, int blk, int G, int& cq, int& giter) {
    int scan = unit >> 1, rh = unit & 1;
    if (G == 256 && unit == blk) { const int x = blk & 7, j = blk >> 3; scan = (j >> 1) * 8 + x; rh = j & 1; }
    const int dir = scan >> 6, bh = scan & 63;
    LAS float* buf = (LAS float*)lds;
    LAS float* ybuf = buf + 2 * RS_CS * 384;
    const float* REC = (const float*)(P.ws + WS_REC) + (size_t)bh * 2048 * 448;
    bf16* Y = (bf16*)(P.ws + WS_RY) + (size_t)dir * MTOK * 512;
    const int b = bh >> 3, h = bh & 7;
    __syncthreads();
    if (wave >= 4) {
        const int st = tid - 256;
        LAS float* scr = (LAS float*)(lds + RS_CONV_OFF + (wave - 4) * 16640);
        const int NCW = G * 4, cw = blk * 4 + (wave - 4);
        const int L = (TRD_N + NCW - 1) / NCW;
        const int TI = RS_NCH * ((256 + G - 1) / G);
        f32x4 v[16]; TrDesc pend; bool have = false;
        f32x4 preA[6], preB[6];
#define RS_ISSUE(pre, chunk) do { _Pragma("unroll") for (int i_ = 0; i_ < 6; ++i_) { const int idx_ = st + 256 * i_; const int s_ = idx_ / 96, rem_ = idx_ - s_ * 96, j_ = rem_ >> 4, q4_ = rem_ & 15; \
        const int step_ = (chunk) * RS_CS + s_; const int t_ = dir ? 2047 - step_ : step_; const int sv_ = (j_ == 0) ? dir : j_ + 1; \
        pre[i_] = *(const f32x4*)(REC + (size_t)t_ * 448 + sv_ * 64 + q4_ * 4); } } while (0)
#define RS_COMMIT(pre, chunk) do { _Pragma("unroll") for (int i_ = 0; i_ < 6; ++i_) { const int idx_ = st + 256 * i_; const int s_ = idx_ / 96, rem_ = idx_ - s_ * 96; \
        *(LAS f32x4*)(buf + ((chunk) & 1) * (RS_CS * 384) + s_ * 384 + rem_ * 4) = pre[i_]; } } while (0)
        auto flush = [&](int chunk) {
            const LAS float* yb = ybuf + (chunk & 1) * (RS_CS * 32);
            if (st < 128) { const int s = st >> 3, q4 = st & 7; const int step = chunk * RS_CS + s; const int t = dir ? 2047 - step : step;
                const f32x4 yv = *(const LAS f32x4*)(yb + s * 32 + q4 * 4); u32x2 yw; yw.x = pg8::cvt_pk_bf16(yv.x, yv.y); yw.y = pg8::cvt_pk_bf16(yv.z, yv.w);
                *(u32x2*)(Y + (size_t)(b * 2048 + t) * 512 + h * 64 + 32 * rh + q4 * 4) = yw; }
        };
        auto convert_step = [&]() {
            if (cq < L && giter >= (int)(((long)cq * TI) / L)) {
                if (have) tr_finish(pend, v, scr, lane);
                const int item = cq * NCW + cw; ++cq;
                have = item < TRD_N;
                if (have) { pend = tr_decode(P, item); tr_issue(pend, v, lane); }
            }
            ++giter;
        };
        RS_ISSUE(preA, 0); RS_ISSUE(preB, 1);
        RS_COMMIT(preA, 0);
        __syncthreads();
        for (int chunk = 0; chunk < RS_NCH; chunk += 2) {
            RS_COMMIT(preB, chunk + 1);
            if (chunk + 2 < RS_NCH) RS_ISSUE(preA, chunk + 2);
            convert_step();
            __syncthreads();
            flush(chunk);
            if (chunk + 2 < RS_NCH) RS_COMMIT(preA, chunk + 2);
            if (chunk + 3 < RS_NCH) RS_ISSUE(preB, chunk + 3);
            convert_step();
            __syncthreads();
            flush(chunk + 1);
        }
        if (have) tr_finish(pend, v, scr, lane);
        __syncthreads();
#undef RS_ISSUE
#undef RS_COMMIT
        return;
    }
    const int kg = lane & 7, lrow = wave * 8 + (lane >> 3), row = 32 * rh + lrow;
    typedef float f2 __attribute__((ext_vector_type(2)));
    f2 S2[4];
#pragma unroll
    for (int i = 0; i < 4; ++i) S2[i] = (f2){0.f, 0.f};
    auto compute = [&](int chunk) {
        const LAS float* cb = buf + (chunk & 1) * (RS_CS * 384);
        LAS float* yb = ybuf + (chunk & 1) * (RS_CS * 32);
        float yk0 = 0.f, yk1 = 0.f;
        struct Ops { f32x4 w0, w1, kp0, kp1, kk0, kk1, bv0, bv1, r0, r1; float vt; };
#define RS_LD(o, s_) do { const LAS float* st_ = cb + (s_) * 384 + kg * 8; \
            o.w0 = *(const LAS f32x4*)(st_); o.w1 = *(const LAS f32x4*)(st_ + 4); o.kp0 = *(const LAS f32x4*)(st_ + 64); o.kp1 = *(const LAS f32x4*)(st_ + 68); \
            o.kk0 = *(const LAS f32x4*)(st_ + 128); o.kk1 = *(const LAS f32x4*)(st_ + 132); o.bv0 = *(const LAS f32x4*)(st_ + 192); o.bv1 = *(const LAS f32x4*)(st_ + 196); \
            o.r0 = *(const LAS f32x4*)(st_ + 256); o.r1 = *(const LAS f32x4*)(st_ + 260); o.vt = cb[(s_) * 384 + 320 + row]; } while (0)
#define RS_STEP(o, s_) do { const int sp_ = (s_) - 1; \
            f2 sa2 = S2[0] * (f2){o.kk0.x, o.kk0.y}; \
            float yq = yp.x + yp.y; \
            f2 u0 = S2[0] * (f2){o.w0.x, o.w0.y}; \
            sa2 = S2[1] * (f2){o.kk0.z, o.kk0.w} + sa2; \
            yq += dpp_f<0xB1>(yq); \
            f2 u1 = S2[1] * (f2){o.w0.z, o.w0.w}; \
            sa2 = S2[2] * (f2){o.kk1.x, o.kk1.y} + sa2; \
            yq += dpp_f<0x4E>(yq); \
            f2 u2 = S2[2] * (f2){o.w1.x, o.w1.y}; \
            sa2 = S2[3] * (f2){o.kk1.z, o.kk1.w} + sa2; \
            yq += dpp_f<0x141>(yq); \
            f2 u3 = S2[3] * (f2){o.w1.z, o.w1.w}; \
            const f2 vtv = (f2){o.vt, o.vt}; \
            float sa = sa2.x + sa2.y; \
            u0 = vtv * (f2){o.kp0.x, o.kp0.y} + u0; \
            sa += dpp_f<0xB1>(sa); \
            u1 = vtv * (f2){o.kp0.z, o.kp0.w} + u1; \
            sa += dpp_f<0x4E>(sa); \
            u2 = vtv * (f2){o.kp1.x, o.kp1.y} + u2; \
            sa += dpp_f<0x141>(sa); \
            u3 = vtv * (f2){o.kp1.z, o.kp1.w} + u3; \
            { const bool mine = (kg == (sp_ & 7)); yk0 = (mine && (unsigned)sp_ < 8u) ? yq : yk0; yk1 = (mine && (unsigned)(sp_ - 8) < 8u) ? yq : yk1; } \
            const f2 sav = (f2){-sa, -sa}; \
            S2[0] = sav * (f2){o.bv0.x, o.bv0.y} + u0; \
            S2[1] = sav * (f2){o.bv0.z, o.bv0.w} + u1; \
            S2[2] = sav * (f2){o.bv1.x, o.bv1.y} + u2; \
            S2[3] = sav * (f2){o.bv1.z, o.bv1.w} + u3; \
            yp = S2[0] * (f2){o.r0.x, o.r0.y}; yp = S2[1] * (f2){o.r0.z, o.r0.w} + yp; yp = S2[2] * (f2){o.r1.x, o.r1.y} + yp; yp = S2[3] * (f2){o.r1.z, o.r1.w} + yp; } while (0)
        Ops oa, ob;
        f2 yp = (f2){0.f, 0.f};
        RS_LD(oa, 0);
#pragma unroll 2
        for (int s = 0; s < RS_CS; s += 2) {
            RS_LD(ob, s + 1);
            __builtin_amdgcn_sched_barrier(0);
            RS_STEP(oa, s);
            __builtin_amdgcn_sched_barrier(0);
            { const int sn = (s + 2 < RS_CS) ? s + 2 : s; RS_LD(oa, sn); }
            __builtin_amdgcn_sched_barrier(0);
            RS_STEP(ob, s + 1);
            __builtin_amdgcn_sched_barrier(0);
        }
        { const float yq = sum8(yp.x + yp.y); if (kg == 7) yk1 = yq; }
#undef RS_LD
#undef RS_STEP
        yb[kg * 32 + lrow] = yk0; yb[(kg + 8) * 32 + lrow] = yk1;
    };
    __syncthreads();
    for (int chunk = 0; chunk < RS_NCH; ++chunk) {
        compute(chunk);
        __syncthreads();
    }
    __syncthreads();
    __builtin_amdgcn_s_setprio(0);
}

constexpr int HG_QP = 136, HG_TP = 40;
constexpr int HG_BUF = (3 * 32 * HG_QP + 2 * 128 * HG_TP) * 2 + 128 * 4;
__device__ __forceinline__ void hgrn_unit(const Ptrs& P, LAS unsigned char* lds, int unit, int tid, int lane, int wave) {
    const int dir = unit & 1, bh = unit >> 1, b = bh >> 2, h = bh & 3;
    const bf16* Pb = (const bf16*)(P.ws + WS_P);
    bf16* HO = (bf16*)(P.ws + WS_HO) + (size_t)dir * MTOK * 512;
    const size_t rowb = (size_t)b * 2048;
    const int r32 = lane & 31, hi = lane >> 5;
    __syncthreads();
    if (wave >= 4) {
        const int p = tid - 256, cp = p >> 2, tq = p & 3, ch = 2 * cp;
        unsigned rqA[8], rfA[8], riA[8], rqB[8], rfB[8], riB[8];
#define HG_ISSUE(rq, rf, ri, c) do { _Pragma("unroll") for (int i_ = 0; i_ < 8; ++i_) { const int j_ = 8 * tq + i_; const int t_ = dir ? 2047 - (32 * (c) + j_) : 32 * (c) + j_; \
            const unsigned* pr_ = (const unsigned*)(Pb + (rowb + t_) * PCOLS + h * 128 + ch); rq[i_] = pr_[0]; rf[i_] = pr_[256 + dir * 256]; ri[i_] = pr_[768]; } } while (0)
        auto produce = [&](const unsigned (&rq)[8], const unsigned (&rf)[8], const unsigned (&ri)[8], int c) {
            LAS unsigned char* bufb = lds + (c & 1) * HG_BUF;
            LAS bf16* Qin = (LAS bf16*)bufb; LAS bf16* Kin = Qin + 32 * HG_QP; LAS bf16* Qdec = Kin + 32 * HG_QP; LAS bf16* KstT = Qdec + 32 * HG_QP; LAS bf16* VT = KstT + 128 * HG_TP;
            LAS float* dec = (LAS float*)(VT + 128 * HG_TP);
            float pf0[8], pf1[8], qv0[8], qv1[8], kv0[8], kv1[8];
#pragma unroll
            for (int i = 0; i < 8; ++i) {
                qv0[i] = bflo(rq[i]); qv1[i] = bfhi(rq[i]); kv0[i] = bflo(rf[i]); kv1[i] = bfhi(rf[i]); pf0[i] = 1.0f - kv0[i]; pf1[i] = 1.0f - kv1[i]; }
            { v4u a, b2;
              a.x = (ri[0] & 0xffffu) | (ri[1] << 16); a.y = (ri[2] & 0xffffu) | (ri[3] << 16); a.z = (ri[4] & 0xffffu) | (ri[5] << 16); a.w = (ri[6] & 0xffffu) | (ri[7] << 16);
              b2.x = (ri[0] >> 16) | (ri[1] & 0xffff0000u); b2.y = (ri[2] >> 16) | (ri[3] & 0xffff0000u); b2.z = (ri[4] >> 16) | (ri[5] & 0xffff0000u); b2.w = (ri[6] >> 16) | (ri[7] & 0xffff0000u);
              *(LAS v4u*)(VT + ch * HG_TP + 8 * tq) = a; *(LAS v4u*)(VT + (ch + 1) * HG_TP + 8 * tq) = b2; }
#pragma unroll
            for (int i = 1; i < 8; ++i) { pf0[i] *= pf0[i - 1]; pf1[i] *= pf1[i - 1]; }
            const float a0 = dpp_f<0x00>(pf0[7]), a1 = dpp_f<0x55>(pf0[7]), a2 = dpp_f<0xAA>(pf0[7]), a3 = dpp_f<0xFF>(pf0[7]);
            const float c0 = dpp_f<0x00>(pf1[7]), c1 = dpp_f<0x55>(pf1[7]), c2 = dpp_f<0xAA>(pf1[7]), c3 = dpp_f<0xFF>(pf1[7]);
            const float off0 = (tq > 0 ? a0 : 1.f) * (tq > 1 ? a1 : 1.f) * (tq > 2 ? a2 : 1.f), off1 = (tq > 0 ? c0 : 1.f) * (tq > 1 ? c1 : 1.f) * (tq > 2 ? c2 : 1.f);
            const float eref0 = a0 * a1, eref1 = c0 * c1, elast0 = a2 * a3, elast1 = c2 * c3;
            const float iref0 = __builtin_amdgcn_rcpf(fmaxf(eref0, 1e-30f)), iref1 = __builtin_amdgcn_rcpf(fmaxf(eref1, 1e-30f));
            float ks0[8], ks1[8];
#pragma unroll
            for (int i = 0; i < 8; ++i) { const int j = 8 * tq + i; const float p0 = off0 * pf0[i], p1 = off1 * pf1[i];
                const float e10 = fmaxf(p0 * iref0, 1e-30f), e11 = fmaxf(p1 * iref1, 1e-30f), e20 = __builtin_amdgcn_rcpf(e10), e21 = __builtin_amdgcn_rcpf(e11);
                *(LAS unsigned*)(Qin + j * HG_QP + ch) = pg8::cvt_pk_bf16(qv0[i] * e10, qv1[i] * e11);
                *(LAS unsigned*)(Kin + j * HG_QP + ch) = pg8::cvt_pk_bf16(kv0[i] * e20, kv1[i] * e21);
                *(LAS unsigned*)(Qdec + j * HG_QP + ch) = pg8::cvt_pk_bf16(qv0[i] * p0, qv1[i] * p1);
                ks0[i] = kv0[i] * e20 * elast0; ks1[i] = kv1[i] * e21 * elast1; }
            *(LAS bf16x8*)(KstT + ch * HG_TP + 8 * tq) = pack8(ks0[0], ks0[1], ks0[2], ks0[3], ks0[4], ks0[5], ks0[6], ks0[7]);
            *(LAS bf16x8*)(KstT + (ch + 1) * HG_TP + 8 * tq) = pack8(ks1[0], ks1[1], ks1[2], ks1[3], ks1[4], ks1[5], ks1[6], ks1[7]);
            if (tq == 0) { dec[ch] = eref0 * elast0; dec[ch + 1] = eref1 * elast1; }
        };
        HG_ISSUE(rqA, rfA, riA, 0); HG_ISSUE(rqB, rfB, riB, 1);
        for (int c = 0; c < 64; c += 2) {
            produce(rqA, rfA, riA, c);
            if (c + 2 < 64) HG_ISSUE(rqA, rfA, riA, c + 2);
            __syncthreads();
            produce(rqB, rfB, riB, c + 1);
            if (c + 3 < 64) HG_ISSUE(rqB, rfB, riB, c + 3);
            __syncthreads();
        }
#undef HG_ISSUE
        __syncthreads();
    } else {
        const int dvb = wave;
        f32x16 Sacc[4];
#pragma unroll
        for (int i = 0; i < 4; ++i)
#pragma unroll
            for (int r = 0; r < 16; ++r) Sacc[i][r] = 0.f;
        __syncthreads();
        for (int c = 0; c < 64; ++c) {
            const LAS unsigned char* bufb = lds + (c & 1) * HG_BUF;
            const LAS bf16* Qin = (const LAS bf16*)bufb; const LAS bf16* Kin = Qin + 32 * HG_QP; const LAS bf16* Qdec = Kin + 32 * HG_QP; const LAS bf16* KstT = Qdec + 32 * HG_QP; const LAS bf16* VT = KstT + 128 * HG_TP;
            const LAS float* dec = (const LAS float*)(VT + 128 * HG_TP);
            f32x16 X, o;
#pragma unroll
            for (int r = 0; r < 16; ++r) { X[r] = 0.f; o[r] = 0.f; }
            const LAS bf16* kinp = Kin + r32 * HG_QP + 8 * hi; const LAS bf16* qinp = Qin + r32 * HG_QP + 8 * hi; const LAS bf16* qdp = Qdec + r32 * HG_QP + 4 * hi;
            bf16x8 xa[3], xb[3]; s16x4 qa0[3], qa1[3];
#define HG_LDX(st_, k_) do { xa[st_] = *(const LAS bf16x8*)(kinp + 16 * (k_)); xb[st_] = *(const LAS bf16x8*)(qinp + 16 * (k_)); \
                qa0[st_] = *(const LAS s16x4*)(qdp + 16 * (k_)); qa1[st_] = *(const LAS s16x4*)(qdp + 16 * (k_) + 8); } while (0)
            HG_LDX(0, 0); HG_LDX(1, 1);
            const LAS bf16* vp = VT + (32 * dvb + r32) * HG_TP + 4 * hi;
            s16x4 vq[4];
#pragma unroll
            for (int k = 0; k < 8; ++k) {
                if (k + 2 < 8) HG_LDX((k + 2) % 3, k + 2);
                if (k == 6) { vq[0] = *(const LAS s16x4*)(vp); vq[1] = *(const LAS s16x4*)(vp + 8); vq[2] = *(const LAS s16x4*)(vp + 16); vq[3] = *(const LAS s16x4*)(vp + 24); }
                const int dkt = k >> 1, s2 = k & 1;
                const bf16x8 sb = pack8(Sacc[dkt][8 * s2 + 0], Sacc[dkt][8 * s2 + 1], Sacc[dkt][8 * s2 + 2], Sacc[dkt][8 * s2 + 3], Sacc[dkt][8 * s2 + 4], Sacc[dkt][8 * s2 + 5], Sacc[dkt][8 * s2 + 6], Sacc[dkt][8 * s2 + 7]);
                __builtin_amdgcn_sched_barrier(0);
                X = __builtin_amdgcn_mfma_f32_32x32x16_bf16(xa[k % 3], xb[k % 3], X, 0, 0, 0);
                const bf16x8 af = (bf16x8){qa0[k % 3][0], qa0[k % 3][1], qa0[k % 3][2], qa0[k % 3][3], qa1[k % 3][0], qa1[k % 3][1], qa1[k % 3][2], qa1[k % 3][3]};
                o = __builtin_amdgcn_mfma_f32_32x32x16_bf16(af, sb, o, 0, 0, 0);
                __builtin_amdgcn_sched_barrier(0);
            }
#undef HG_LDX
            const LAS bf16* ksp = KstT + r32 * HG_TP + 8 * hi; const LAS bf16* vtp = VT + (32 * dvb + r32) * HG_TP + 8 * hi;
            const bf16x8 bv0 = *(const LAS bf16x8*)(vtp), bv1 = *(const LAS bf16x8*)(vtp + 16);
            bf16x8 ka[2][2]; f32x4 dq[2][4];
#define HG_LDS(st_, dkt_) do { ka[st_][0] = *(const LAS bf16x8*)(ksp + (32 * (dkt_)) * HG_TP); ka[st_][1] = *(const LAS bf16x8*)(ksp + (32 * (dkt_)) * HG_TP + 16); \
                _Pragma("unroll") for (int g = 0; g < 4; ++g) dq[st_][g] = *(const LAS f32x4*)(dec + 32 * (dkt_) + 8 * g + 4 * hi); } while (0)
            HG_LDS(0, 0);
            __builtin_amdgcn_sched_barrier(0);
#pragma unroll
            for (int r = 0; r < 16; ++r) if (crow(r, hi) > r32) X[r] = 0.f;
            const bf16x8 pa0 = pack8(X[0], X[1], X[2], X[3], X[4], X[5], X[6], X[7]);
            const bf16x8 pa1 = pack8(X[8], X[9], X[10], X[11], X[12], X[13], X[14], X[15]);
            {
                const bf16x8 vb0 = (bf16x8){vq[0][0], vq[0][1], vq[0][2], vq[0][3], vq[1][0], vq[1][1], vq[1][2], vq[1][3]};
                const bf16x8 vb1 = (bf16x8){vq[2][0], vq[2][1], vq[2][2], vq[2][3], vq[3][0], vq[3][1], vq[3][2], vq[3][3]};
                o = __builtin_amdgcn_mfma_f32_32x32x16_bf16(pa0, vb0, o, 0, 0, 0);
                o = __builtin_amdgcn_mfma_f32_32x32x16_bf16(pa1, vb1, o, 0, 0, 0);
            }
#pragma unroll
            for (int dkt = 0; dkt < 4; ++dkt) {
                if (dkt + 1 < 4) HG_LDS((dkt + 1) & 1, dkt + 1);
#pragma unroll
                for (int g = 0; g < 4; ++g) { const f32x4 d4 = dq[dkt & 1][g];
                    Sacc[dkt][4 * g + 0] *= d4.x; Sacc[dkt][4 * g + 1] *= d4.y; Sacc[dkt][4 * g + 2] *= d4.z; Sacc[dkt][4 * g + 3] *= d4.w; }
                __builtin_amdgcn_sched_barrier(0);
                Sacc[dkt] = __builtin_amdgcn_mfma_f32_32x32x16_bf16(ka[dkt & 1][0], bv0, Sacc[dkt], 0, 0, 0);
                Sacc[dkt] = __builtin_amdgcn_mfma_f32_32x32x16_bf16(ka[dkt & 1][1], bv1, Sacc[dkt], 0, 0, 0);
                if (dkt == 0) {
#pragma unroll
                    for (int r = 0; r < 16; ++r) { const int j = crow(r, hi); const int t = dir ? 2047 - (32 * c + j) : 32 * c + j;
                        ((unsigned short*)HO)[(rowb + t) * 512 + h * 128 + 32 * dvb + r32] = (unsigned short)(pg8::cvt_pk_bf16(o[r], 0.f) & 0xffffu); }
                }
                __builtin_amdgcn_sched_barrier(0);
            }
#undef HG_LDS
            __syncthreads();
        }
    }
    __syncthreads();
}

__device__ __forceinline__ void p5_combine(const Ptrs& P, int lane, int wave, int blk, int G) {
    const bf16* HOf = (const bf16*)(P.ws + WS_HO); const bf16* HOb = HOf + (size_t)MTOK * 512;
    const bf16* Yf = (const bf16*)(P.ws + WS_RY); const bf16* Yb = Yf + (size_t)MTOK * 512;
    const unsigned* RG = (const unsigned*)(P.ws + WS_RG); const float* RBON = (const float*)(P.ws + WS_RBON); const float* REC = (const float*)(P.ws + WS_REC);
    const bf16* Pb = (const bf16*)(P.ws + WS_P); bf16* YM = (bf16*)(P.ws + WS_YMIX);
    const float* hng = P.in[15]; const float* lng = P.in[25]; const float* lnb = P.in[26];
#pragma unroll 2
    for (int m = blk * 8 + wave; m < MTOK; m += G * 8) {
        {
            const int c0 = lane * 8;
            const v4u aw = *(const v4u*)(HOf + (size_t)m * 512 + c0), bw = *(const v4u*)(HOb + (size_t)m * 512 + c0);
            const f32x4 a0 = (f32x4){bflo(aw.x), bfhi(aw.x), bflo(aw.y), bfhi(aw.y)}, a1 = (f32x4){bflo(aw.z), bfhi(aw.z), bflo(aw.w), bfhi(aw.w)};
            const f32x4 b0 = (f32x4){bflo(bw.x), bfhi(bw.x), bflo(bw.y), bfhi(bw.y)}, b1 = (f32x4){bflo(bw.z), bfhi(bw.z), bflo(bw.w), bfhi(bw.w)};
            float o[8] = {a0.x + b0.x, a0.y + b0.y, a0.z + b0.z, a0.w + b0.w, a1.x + b1.x, a1.y + b1.y, a1.z + b1.z, a1.w + b1.w};
            float ss = 0.f;
#pragma unroll
            for (int i = 0; i < 8; ++i) ss += o[i] * o[i];
            ss = sum16(ss);
            const float rstd = 1.0f / sqrtf(ss * (1.0f / 128.0f) + 1e-6f);
            const v4u gw = *(const v4u*)(Pb + (size_t)m * PCOLS + 2048 + c0);
            const float g[8] = {bflo(gw.x), bfhi(gw.x), bflo(gw.y), bfhi(gw.y), bflo(gw.z), bfhi(gw.z), bflo(gw.w), bfhi(gw.w)};
            const int cn = (lane & 15) * 8;
            float y[8];
#pragma unroll
            for (int i = 0; i < 8; ++i) y[i] = o[i] * rstd * hng[cn + i] * g[i];
            *(bf16x8*)(YM + (size_t)m * 1024 + c0) = pack8(y[0], y[1], y[2], y[3], y[4], y[5], y[6], y[7]);
        }
        {
            const int c0 = lane * 8, hh = lane >> 3;
            const v4u ya = *(const v4u*)(Yf + (size_t)m * 512 + c0), yb2 = *(const v4u*)(Yb + (size_t)m * 512 + c0);
            float y[8] = {bflo(ya.x) + bflo(yb2.x), bfhi(ya.x) + bfhi(yb2.x), bflo(ya.y) + bflo(yb2.y), bfhi(ya.y) + bfhi(yb2.y), bflo(ya.z) + bflo(yb2.z), bfhi(ya.z) + bfhi(yb2.z), bflo(ya.w) + bflo(yb2.w), bfhi(ya.w) + bfhi(yb2.w)};
            float s = 0.f;
#pragma unroll
            for (int i = 0; i < 8; ++i) s += y[i];
            s = sum8(s);
            const float mean = s * (1.0f / 64.0f);
            float q = 0.f;
#pragma unroll
            for (int i = 0; i < 8; ++i) { y[i] -= mean; q += y[i] * y[i]; }
            q = sum8(q);
            const float rstd = 1.0f / sqrtf(q * (1.0f / 64.0f) + 64e-5f);
            const float bon = RBON[(size_t)m * 8 + hh];
            const int b = m >> 11, t = m & 2047;
            const float* vr = REC + ((size_t)(b * 8 + hh) * 2048 + t) * 448 + 384 + (lane & 7) * 8;
            const f32x4 v0 = *(const f32x4*)vr, v1 = *(const f32x4*)(vr + 4);
            const v4u gw0 = *(const v4u*)(RG + (size_t)m * 256 + 32 * hh + (lane & 3) * 8), gw1 = *(const v4u*)(RG + (size_t)m * 256 + 32 * hh + (lane & 3) * 8 + 4); const bool ghi = (lane & 4) != 0;
            const f32x4 g0 = ghi ? (f32x4){bfhi(gw0.x), bfhi(gw0.y), bfhi(gw0.z), bfhi(gw0.w)} : (f32x4){bflo(gw0.x), bflo(gw0.y), bflo(gw0.z), bflo(gw0.w)};
            const f32x4 g1 = ghi ? (f32x4){bfhi(gw1.x), bfhi(gw1.y), bfhi(gw1.z), bfhi(gw1.w)} : (f32x4){bflo(gw1.x), bflo(gw1.y), bflo(gw1.z), bflo(gw1.w)};
            const float vv[8] = {v0.x, v0.y, v0.z, v0.w, v1.x, v1.y, v1.z, v1.w}, gg[8] = {g0.x, g0.y, g0.z, g0.w, g1.x, g1.y, g1.z, g1.w};
            float z[8];
#pragma unroll
            for (int i = 0; i < 8; ++i) z[i] = (y[i] * rstd * lng[c0 + i] + lnb[c0 + i] + bon * vv[i]) * gg[i];
            *(bf16x8*)(YM + (size_t)m * 1024 + 512 + c0) = pack8(z[0], z[1], z[2], z[3], z[4], z[5], z[6], z[7]);
        }
    }
}
constexpr int LC_TILE = 0, LC_SEG = 2048, LC_HIST = 2304, LC_BASE = 2432, LC_TOTAL = 2560, LC_LOG = 2816, LC_PE = 6912, LC_PW = 7936, LC_PLR = 8960, LC_MISC = 12288;

__device__ __forceinline__ void p7_router(const Ptrs& P, LAS unsigned char* lds, int layer, const bf16* xin, int tid, int lane, int wave, int blk, int G) {
    LAS float* eg = (LAS float*)lds; LAS float* sh = eg + 1024;
    LAS float* tile = (LAS float*)(lds + 8192);
    LAS unsigned char* lc = lds + LDSCTL_OFF;
    LAS int* hist = (LAS int*)(lc + LC_HIST); LAS int* base = (LAS int*)(lc + LC_BASE);
    LAS float* lgall = (LAS float*)(lc + LC_LOG);
    LAS int* pe = (LAS int*)(lc + LC_PE); LAS float* pw = (LAS float*)(lc + LC_PW); LAS int* plr = (LAS int*)(lc + LC_PLR);
    bf16* H = (bf16*)(P.ws + WS_H);
    const float* Wr = P.in[6] + (size_t)layer * 1024 * 32; const float* rb_ = P.in[7] + layer * 32;
    unsigned* cnt = (unsigned*)(P.ws + WS_CTL) + CW_CNT + layer * 64;
    int* TE = (int*)(P.ws + WS_ROUTE + RT_E); float* TW = (float*)(P.ws + WS_ROUTE + RT_W); int* TR = (int*)(P.ws + WS_ROUTE + RT_RANK); int* SX = (int*)(P.ws + WS_SIDXS);
    for (int rb = blk; rb < 256; rb += G) {
        const int b = rb >> 5;
        __syncthreads();
        load_mod_vec<false>(P, eg, sh, P.in[5] + layer * 1024, layer, b, 3, tid);
        if (tid < 32) hist[tid] = 0;
        __syncthreads();
        for (int pass = 0; pass < 2; ++pass) {
            f32x4 vr[4][4];
#pragma unroll
            for (int i = 0; i < 4; ++i) { const int m = rb * 64 + wave * 8 + pass * 4 + i; ld_row_bf16(xin + (size_t)m * 1024, vr[i], lane); }
#pragma unroll
            for (int i = 0; i < 4; ++i) { const int m = rb * 64 + wave * 8 + pass * 4 + i, lr = wave * 4 + i;
                const float rstd = row_rstd(vr[i]);
                store_h_row(H + (size_t)m * 1024, vr[i], rstd, eg, sh, lane);
#pragma unroll
                for (int j = 0; j < 4; ++j) { const int c = lane + 64 * j, k = 4 * c; const f32x4 g = *(const LAS f32x4*)(eg + k), s = *(const LAS f32x4*)(sh + k);
                    f32x4 o; o.x = vr[i][j].x * rstd * g.x + s.x; o.y = vr[i][j].y * rstd * g.y + s.y; o.z = vr[i][j].z * rstd * g.z + s.z; o.w = vr[i][j].w * rstd * g.w + s.w;
                    *(LAS f32x4*)(tile + lr * 1024 + ((c ^ (lr & 15)) << 2)) = o; } }
            __syncthreads();
            f32x16 acc;
#pragma unroll
            for (int r = 0; r < 16; ++r) acc[r] = 0.f;
            { const int ri = lane & 31, hh = lane >> 5;
              const float* wp = Wr + (size_t)(128 * wave + 4 * hh) * 32 + ri;
              float wv[2][16];
#pragma unroll
              for (int q = 0; q < 16; ++q) wv[0][q] = wp[(size_t)(8 * (q >> 2) + (q & 3)) * 32];
#pragma unroll
              for (int gq = 0; gq < 4; ++gq) { const int u0 = 4 * gq;
                  if (gq < 3) {
#pragma unroll
                      for (int q = 0; q < 16; ++q) wv[(gq + 1) & 1][q] = wp[(size_t)(8 * (u0 + 4 + (q >> 2)) + (q & 3)) * 32]; }
#pragma unroll
                  for (int uu = 0; uu < 4; ++uu) { const int c = 32 * wave + 2 * (u0 + uu) + hh;
                      const f32x4 a = *(const LAS f32x4*)(tile + ri * 1024 + ((c ^ (ri & 15)) << 2));
                      acc = __builtin_amdgcn_mfma_f32_32x32x2f32(a.x, wv[gq & 1][4 * uu + 0], acc, 0, 0, 0); acc = __builtin_amdgcn_mfma_f32_32x32x2f32(a.y, wv[gq & 1][4 * uu + 1], acc, 0, 0, 0);
                      acc = __builtin_amdgcn_mfma_f32_32x32x2f32(a.z, wv[gq & 1][4 * uu + 2], acc, 0, 0, 0); acc = __builtin_amdgcn_mfma_f32_32x32x2f32(a.w, wv[gq & 1][4 * uu + 3], acc, 0, 0, 0); }
              } }
            __syncthreads();
#pragma unroll
            for (int r = 0; r < 16; ++r) tile[(wave * 16 + r) * 64 + lane] = acc[r];
            __syncthreads();
#pragma unroll
            for (int oo = 0; oo < 2; ++oo) { const int o = tid + 512 * oo, row = o >> 5, e = o & 31, r = (row & 3) + 4 * (row >> 3), lp = e + 32 * ((row >> 2) & 1);
                float s = rb_[e];
#pragma unroll
                for (int w = 0; w < 8; ++w) s += tile[(w * 16 + r) * 64 + lp];
                lgall[row * 32 + e] = s; }
            __syncthreads();
            if (tid < 32) {
                const LAS float* lr = lgall + tid * 32;
                float v0 = -3e38f, v1 = -3e38f, v2 = -3e38f, v3 = -3e38f; int i0 = 0, i1 = 0, i2 = 0, i3 = 0;
                for (int q = 0; q < 32; ++q) { const float x = lr[q];
                    if (x > v0) { v3 = v2; i3 = i2; v2 = v1; i2 = i1; v1 = v0; i1 = i0; v0 = x; i0 = q; }
                    else if (x > v1) { v3 = v2; i3 = i2; v2 = v1; i2 = i1; v1 = x; i1 = q; }
                    else if (x > v2) { v3 = v2; i3 = i2; v2 = x; i2 = q; }
                    else if (x > v3) { v3 = x; i3 = q; } }
                const float e1 = expf_(v1 - v0), e2 = expf_(v2 - v0), e3 = expf_(v3 - v0), inv = 1.0f / (1.0f + e1 + e2 + e3);
                const int lrow = (tid >> 2) * 8 + pass * 4 + (tid & 3);
                pe[lrow * 4 + 0] = i0; pe[lrow * 4 + 1] = i1; pe[lrow * 4 + 2] = i2; pe[lrow * 4 + 3] = i3;
                pw[lrow * 4 + 0] = inv; pw[lrow * 4 + 1] = e1 * inv; pw[lrow * 4 + 2] = e2 * inv; pw[lrow * 4 + 3] = e3 * inv;
                plr[lrow * 4 + 0] = __hip_atomic_fetch_add(hist + i0, 1, __ATOMIC_RELAXED, __HIP_MEMORY_SCOPE_WORKGROUP); plr[lrow * 4 + 1] = __hip_atomic_fetch_add(hist + i1, 1, __ATOMIC_RELAXED, __HIP_MEMORY_SCOPE_WORKGROUP);
                plr[lrow * 4 + 2] = __hip_atomic_fetch_add(hist + i2, 1, __ATOMIC_RELAXED, __HIP_MEMORY_SCOPE_WORKGROUP); plr[lrow * 4 + 3] = __hip_atomic_fetch_add(hist + i3, 1, __ATOMIC_RELAXED, __HIP_MEMORY_SCOPE_WORKGROUP);
            }
            __syncthreads();
        }
        __syncthreads();
        if (tid < 32) base[tid] = (int)__hip_atomic_fetch_add(cnt + tid, (unsigned)hist[tid], __ATOMIC_RELAXED, __HIP_MEMORY_SCOPE_AGENT);
        __syncthreads();
        if (tid < 256) { const int lrow = tid >> 2, sl = tid & 3; const int m = rb * 64 + lrow; const int ee = pe[lrow * 4 + sl];
            const int rk = base[ee] + plr[lrow * 4 + sl];
            TE[m * 4 + sl] = ee; TW[m * 4 + sl] = pw[lrow * 4 + sl]; TR[m * 4 + sl] = rk; SX[ee * 16384 + rk] = m; }
    }
}

__device__ __forceinline__ int moe_tables(const Ptrs& P, LAS unsigned char* lds, int layer, int tid) {
    LAS unsigned char* lc = lds + LDSCTL_OFF;
    LAS int* tile_exp = (LAS int*)(lc + LC_TILE); LAS int* seg = (LAS int*)(lc + LC_SEG); LAS int* tot = (LAS int*)(lc + LC_TOTAL);
    const unsigned* cnt = (const unsigned*)(P.ws + WS_CTL) + CW_CNT + layer * 64;
    __syncthreads();
    if (tid < 32) {
        int ts = 0, mine = 0, c_mine = 0;
        for (int e = 0; e < 32; ++e) { const int c = (int)__hip_atomic_load(cnt + e, __ATOMIC_RELAXED, __HIP_MEMORY_SCOPE_AGENT); const int nt = (c + 255) >> 8; if (e < tid) ts += nt; if (e == tid) { mine = nt; c_mine = c; } }
        seg[tid] = ts * 256;
        for (int i = 0; i < mine; ++i) tile_exp[ts + i] = tid + (i << 8) + (((c_mine - i * 256 < 256 ? c_mine - i * 256 : 256) - 1) << 16);
        if (tid == 31) tot[0] = ts + mine;
    }
    __syncthreads();
    return tot[0];
}

__device__ __forceinline__ int moe_tables_again(const Ptrs& P, LAS unsigned char* lds, int layer, int tid) {
#if MK_N_LAUNCHES == 1
    (void)P; (void)layer; (void)tid; __syncthreads(); return ((const LAS int*)(lds + LDSCTL_OFF + LC_TOTAL))[0];
#else
    return moe_tables(P, lds, layer, tid);
#endif
}
template <bool FINAL>
__device__ __forceinline__ void p11_moe_combine(const Ptrs& P, LAS unsigned char* lds, int layer, const bf16* x1, bf16* xout, int tid, int lane, int wave, int blk, int G) {
    LAS float* eg = (LAS float*)lds; LAS float* sh = eg + 1024; LAS float* gf = sh + 1024;
    const bf16* EO = (const bf16*)(P.ws + WS_EO); const int* TE = (const int*)(P.ws + WS_ROUTE + RT_E); const float* TW = (const float*)(P.ws + WS_ROUTE + RT_W); const int* TR = (const int*)(P.ws + WS_ROUTE + RT_RANK);
    (void)moe_tables_again(P, lds, layer, tid);
    const LAS int* seg = (const LAS int*)(lds + LDSCTL_OFF + LC_SEG);
    const float* mod = (const float*)(P.ws + WS_MOD);
    bf16* H = (bf16*)(P.ws + WS_H);
    for (int rb = blk; rb < 256; rb += G) {
        const int b = rb >> 5;
        __syncthreads();
        if (FINAL) { for (int k = tid; k < 1024; k += 512) { eg[k] = P.in[32][k]; sh[k] = 0.f; } }
        else load_mod_vec<false>(P, eg, sh, P.in[4] + (layer + 1) * 1024, layer + 1, b, 0, tid);
        for (int k = tid; k < 1024; k += 512) gf[k] = mod[((size_t)layer * 8 + b) * 6144 + 5120 + k];
        __syncthreads();
#pragma unroll 2
        for (int i = 0; i < 8; ++i) { const int m = rb * 64 + wave * 8 + i;
            f32x4 v[4], s[4];
            ld_row_bf16(x1 + (size_t)m * 1024, v, lane);
#pragma unroll
            for (int j = 0; j < 4; ++j) s[j] = (f32x4){0.f, 0.f, 0.f, 0.f};
#pragma unroll
            for (int sl = 0; sl < 4; ++sl) { const int pos = seg[TE[m * 4 + sl]] + TR[m * 4 + sl]; const float wg = TW[m * 4 + sl]; const u32x2* er = (const u32x2*)(EO + (size_t)pos * 1024) + lane;
#pragma unroll
                for (int j = 0; j < 4; ++j) { const u32x2 w = er[64 * j]; s[j].x += wg * bflo(w.x); s[j].y += wg * bfhi(w.x); s[j].z += wg * bflo(w.y); s[j].w += wg * bfhi(w.y); } }
#pragma unroll
            for (int j = 0; j < 4; ++j) { const f32x4 g = *(const LAS f32x4*)(gf + 4 * lane + 256 * j); v[j] = v[j] + g * s[j]; }
            const float rstd = row_rstd(v);
            if (FINAL) {
                f32x4* orow = (f32x4*)(P.out + (size_t)m * 1024) + lane;
#pragma unroll
                for (int j = 0; j < 4; ++j) { const f32x4 g = *(const LAS f32x4*)(eg + 4 * lane + 256 * j); orow[64 * j] = v[j] * rstd * g; }
            } else {
                st_row_bf16(xout + (size_t)m * 1024, v, lane);
                store_h_row(H + (size_t)m * 1024, v, rstd, eg, sh, lane);
            }
        }
    }
}
constexpr int AT_KP = 136, AT_VP = 160;
constexpr int AT_K_OFF = 0, AT_V_OFF = 64 * AT_KP * 2, AT_B_OFF = AT_V_OFF + 64 * AT_VP * 2, AT_X_OFF = AT_B_OFF + 4096 * 4, AT_END = AT_X_OFF + 4 * 64 * 64 * 4;
static_assert(AT_END <= SCR_BYTES, "attention LDS");
__device__ __forceinline__ bf16x8 vtr_pair(const LAS bf16* p) {
    typedef short v4i16_t __attribute__((ext_vector_type(4)));
    const s16x4 lo = __builtin_bit_cast(s16x4, __builtin_amdgcn_ds_read_tr16_b64_v4i16((LAS v4i16_t*)p));
    const s16x4 hi = __builtin_bit_cast(s16x4, __builtin_amdgcn_ds_read_tr16_b64_v4i16((LAS v4i16_t*)(p + 8 * AT_VP)));
    return (bf16x8){lo[0], lo[1], lo[2], lo[3], hi[0], hi[1], hi[2], hi[3]};
}
__device__ __forceinline__ void attn_phase(const Ptrs& P, LAS unsigned char* lds, int tid, int lane, int wave, int blk, int G) {
    LAS bf16* Kt = (LAS bf16*)(lds + AT_K_OFF); LAS bf16* Vt = (LAS bf16*)(lds + AT_V_OFF);
    LAS float* biasL = (LAS float*)(lds + AT_B_OFF); LAS float* xch = (LAS float*)(lds + AT_X_OFF);
    const bf16* Qg = (const bf16*)(P.ws + WS_P); const bf16* Kg = Qg + (size_t)MTOK * 1024; const bf16* Vg = Kg + (size_t)MTOK * 1024;
    bf16* AO = (bf16*)(P.ws + WS_YMIX);
    const float* biasT = (const float*)(P.ws + WS_BIAS);
    const int r32 = lane & 31, hi = lane >> 5, mp = wave & 1, qs = wave >> 1;
    float lam_full;
    { const float* lm = P.in[29]; const float s1 = wave_sum(lm[lane] * lm[64 + lane]), s2 = wave_sum(lm[128 + lane] * lm[192 + lane]); lam_full = expf_(s1) - expf_(s2) + LAM_INIT; }
    const int trow = 4 * hi + ((lane & 15) >> 2), tcol = 16 * ((lane >> 4) & 1) + 4 * (lane & 3);
    for (int ui = 0; ui * G + blk < 1024; ++ui) {
        int unit = ui * G + blk;
        if (G == 256) { const int x = blk & 7, idx = ui * 32 + (blk >> 3); unit = ((x + 8 * (idx >> 4)) << 4) | (idx & 15); }
        const int bh = unit >> 4, qb = unit & 15, b = bh >> 3, h = bh & 7, q0 = qb * 128;
        const size_t rowb = (size_t)b * 2048;
        __syncthreads();
        for (int i = tid; i < 1024; i += 512) *(LAS f32x4*)(biasL + 4 * i) = *(const f32x4*)(biasT + h * 4096 + 4 * i);
        const int qrow = q0 + qs * 32 + r32;
        bf16x8 qf[4];
#pragma unroll
        for (int ks = 0; ks < 4; ++ks) qf[ks] = *(const bf16x8*)(Qg + (rowb + qrow) * 1024 + h * 128 + mp * 64 + 16 * ks + 8 * hi);
        f32x16 oT[4];
#pragma unroll
        for (int d = 0; d < 4; ++d)
#pragma unroll
            for (int r = 0; r < 16; ++r) oT[d][r] = 0.f;
        float lsum = 0.f, cb_cur = 0.f; int cls_prev = 0;
        f32x16 negmc;
#pragma unroll
        for (int r = 0; r < 16; ++r) negmc[r] = 0.f;
        v4u pk[2], pv[2];
        auto issue = [&](int kt) {
#pragma unroll
            for (int i = 0; i < 2; ++i) { const int idx = tid + 512 * i, row = idx >> 4, c16 = idx & 15;
                pk[i] = *(const v4u*)(Kg + (rowb + kt * 64 + row) * 1024 + h * 128 + c16 * 8);
                pv[i] = *(const v4u*)(Vg + (rowb + kt * 64 + row) * 1024 + h * 128 + c16 * 8); }
        };
        issue(0);
        for (int kt = 0; kt < 32; ++kt) {
            __syncthreads();
#pragma unroll
            for (int i = 0; i < 2; ++i) { const int idx = tid + 512 * i, row = idx >> 4, c16 = idx & 15;
                *(LAS v4u*)(Kt + row * AT_KP + c16 * 8) = pk[i]; *(LAS v4u*)(Vt + row * AT_VP + c16 * 8) = pv[i]; }
            __syncthreads();
            if (kt + 1 < 32) issue(kt + 1);
            const int k0 = kt * 64, qw0 = q0 + qs * 32;
            const int cls = (k0 - (qw0 + 31) >= 128) ? 1 : (qw0 - (k0 + 63) >= 128) ? 2 : 0;
            if (cls != cls_prev) {
                const float cbn = cls == 1 ? biasL[2047 + 128] : cls == 2 ? biasL[2047 - 128] : 0.f, dcb = cbn - cb_cur;
#pragma unroll
                for (int r = 0; r < 16; ++r) negmc[r] += dcb;
                cb_cur = cbn; cls_prev = cls;
            }
            f32x16 p0, p1;
#pragma unroll
            for (int ks = 0; ks < 4; ++ks) {
                const bf16x8 a0 = *(const LAS bf16x8*)(Kt + r32 * AT_KP + mp * 64 + 16 * ks + 8 * hi);
                const bf16x8 a1 = *(const LAS bf16x8*)(Kt + (32 + r32) * AT_KP + mp * 64 + 16 * ks + 8 * hi);
                if (ks == 0) { p0 = __builtin_amdgcn_mfma_f32_32x32x16_bf16(a0, qf[ks], negmc, 0, 0, 0); p1 = __builtin_amdgcn_mfma_f32_32x32x16_bf16(a1, qf[ks], negmc, 0, 0, 0); }
                else { p0 = __builtin_amdgcn_mfma_f32_32x32x16_bf16(a0, qf[ks], p0, 0, 0, 0); p1 = __builtin_amdgcn_mfma_f32_32x32x16_bf16(a1, qf[ks], p1, 0, 0, 0); }
            }
            if (cls == 0) { const LAS float* bp = biasL + (k0 - qrow + 2047);
#pragma unroll
                for (int r = 0; r < 16; ++r) { p0[r] += bp[crow(r, hi)]; p1[r] += bp[32 + crow(r, hi)]; } }
#define AT_MX3(a_, b_, c_) __builtin_fmaxf(__builtin_fmaxf((a_), (b_)), (c_))
            float mxa = AT_MX3(p0[0], p0[1], p1[0]), mxb = AT_MX3(p0[2], p0[3], p1[1]); mxa = AT_MX3(mxa, p1[2], p1[3]);
#pragma unroll
            for (int r = 4; r < 16; r += 4) { mxa = AT_MX3(mxa, p0[r], p0[r + 1]); mxb = AT_MX3(mxb, p0[r + 2], p0[r + 3]); mxa = AT_MX3(mxa, p1[r], p1[r + 1]); mxb = AT_MX3(mxb, p1[r + 2], p1[r + 3]); }
#undef AT_MX3
            float mx = __builtin_fmaxf(mxa, mxb);
            { const auto rr = __builtin_amdgcn_permlane32_swap(__float_as_uint(mx), __float_as_uint(mx), false, false); mx = __builtin_fmaxf(__uint_as_float(rr[0]), __uint_as_float(rr[1])); }
            if (kt == 0 || __any(mx > 8.0f)) {
                const float dl = (kt == 0) ? mx : fmaxf(mx, 0.f), f = __builtin_amdgcn_exp2f(-dl);
#pragma unroll
                for (int r = 0; r < 16; ++r) { p0[r] -= dl; p1[r] -= dl; negmc[r] -= dl; }
                lsum *= f;
#pragma unroll
                for (int d = 0; d < 4; ++d)
#pragma unroll
                    for (int r = 0; r < 16; ++r) oT[d][r] *= f;
            }
            float ps = 0.f;
#pragma unroll
            for (int r = 0; r < 16; ++r) { p0[r] = __builtin_amdgcn_exp2f(p0[r]); p1[r] = __builtin_amdgcn_exp2f(p1[r]); ps += p0[r] + p1[r]; }
            lsum += ps;
            bf16x8 pb[4];
            pb[0] = pack8(p0[0], p0[1], p0[2], p0[3], p0[4], p0[5], p0[6], p0[7]); pb[1] = pack8(p0[8], p0[9], p0[10], p0[11], p0[12], p0[13], p0[14], p0[15]);
            pb[2] = pack8(p1[0], p1[1], p1[2], p1[3], p1[4], p1[5], p1[6], p1[7]); pb[3] = pack8(p1[8], p1[9], p1[10], p1[11], p1[12], p1[13], p1[14], p1[15]);
#pragma unroll
            for (int d = 0; d < 4; ++d)
#pragma unroll
                for (int st = 0; st < 4; ++st) {
                    const bf16x8 va = vtr_pair(Vt + (16 * st + trow) * AT_VP + 32 * d + tcol);
                    oT[d] = __builtin_amdgcn_mfma_f32_32x32x16_bf16(va, pb[st], oT[d], 0, 0, 0);
                }
        }
        lsum = sum_halves(lsum);
        const float inv = 1.0f / lsum;
        __syncthreads();
        if (mp == 1) {
#pragma unroll
            for (int d = 0; d < 4; ++d)
#pragma unroll
                for (int r = 0; r < 16; ++r) xch[(qs * 64 + d * 16 + r) * 64 + lane] = oT[d][r] * inv;
        }
        __syncthreads();
        if (mp == 0) {
            float ss = 0.f;
#pragma unroll
            for (int d = 0; d < 4; ++d)
#pragma unroll
                for (int r = 0; r < 16; ++r) { const float o = oT[d][r] * inv - lam_full * xch[(qs * 64 + d * 16 + r) * 64 + lane]; oT[d][r] = o; ss += o * o; }
            ss = sum_halves(ss);
            const float sc = (1.0f - LAM_INIT) / sqrtf(ss * (1.0f / 128.0f) + 1e-6f);
            bf16* orow = AO + (rowb + qrow) * 1024 + h * 128;
#pragma unroll
            for (int d = 0; d < 4; ++d)
#pragma unroll
                for (int g = 0; g < 4; ++g) { const int dv = 32 * d + 8 * g + 4 * hi; const f32x4 sg = *(const f32x4*)(P.in[30] + dv);
                    u32x2 w; w.x = pg8::cvt_pk_bf16(oT[d][4 * g] * sc * sg.x, oT[d][4 * g + 1] * sc * sg.y); w.y = pg8::cvt_pk_bf16(oT[d][4 * g + 2] * sc * sg.z, oT[d][4 * g + 3] * sc * sg.w);
                    *(u32x2*)(orow + dv) = w; }
        }
    }
    __syncthreads();
}
#ifndef MK_N_LAUNCHES
#define MK_N_LAUNCHES 1
#endif
constexpr int N_PHASES = 20;
struct Args { Ptrs p; int ph_lo, ph_hi; };
__global__ void __launch_bounds__(512, 2) mk_fwd(Args args) {
    extern __shared__ __attribute__((aligned(16))) unsigned char lds_raw[];
    LAS unsigned char* lds = (LAS unsigned char*)lds_raw;
    const Ptrs& P = args.p;
    const int tid = threadIdx.x, lane = tid & 63, wave = __builtin_amdgcn_readfirstlane(tid >> 6), blk = blockIdx.x, G = gridDim.x;
    const int lo = args.ph_lo, hi = args.ph_hi;
    unsigned char* ws = P.ws;
    for (int u = tid; u < (LDS_BYTES - LDSCTL_OFF) / 4; u += 512) ((LAS unsigned*)(lds + LDSCTL_OFF))[u] = 0u;
    __syncthreads();
    XcdBarrier bar; bar.bar = (unsigned*)(ws + WS_CTL) + CW_BAR; bar.x = 0; bar.st = nullptr;
    if (hi - lo > 1) bar = xcd_barrier_post((unsigned*)(ws + WS_CTL) + CW_BAR, (volatile LAS unsigned*)(lds + LDSCTL_OFF + LC_MISC) + 8);
#define IN(k) (lo <= (k) && (k) < hi)
#define SEAM(k) do { if (IN(k) && IN((k) + 1)) xcd_barrier(bar); } while (0)
    bf16* const Hb = (bf16*)(ws + WS_H);
    bf16* const XA = (bf16*)(ws + WS_XA); bf16* const XB = (bf16*)(ws + WS_XB);
    const float* const mod = (const float*)(ws + WS_MOD);

    if (IN(0)) { p0_prologue(P, lds, tid, lane, wave, blk, G); } SEAM(0);
    if (IN(1)) { p1_norm0(P, lds, tid, lane, wave, blk, G); } SEAM(1);
    if (IN(2)) {
        pg8::Gemm g{Hb, (const bf16*)(ws + WS_WAB), MTOK, PCOLS, 1024}; pg8::StaticOrder S; S.init(MTOK, PCOLS, G, blk);
        pg8::EpiP E{(bf16*)(ws + WS_P), PCOLS, P.in[14]};
        pg8::gemm_phase<pg8::EpiP, pg8::StaticOrder, true, true>(lds, g, S, E);
    } SEAM(2);
    if (IN(3)) {
        const int NH = (G >= 128) ? 64 : (G > 1 ? G / 2 : 1);
        if (blk < NH) { for (int u = blk; u < 64; u += NH) hgrn_unit(P, lds, u, tid, lane, wave); }
        if (blk >= NH || G == 1) p3_rwkv_prep(P, lds, tid, lane, wave, G == 1 ? 0 : blk - NH, G == 1 ? 1 : G - NH);
    } SEAM(3);
    if (IN(4)) {
        { int cq = 0, giter = 0; for (int u = blk; u < 256; u += G) rwkv_scan_unit(P, lds, u, tid, lane, wave, blk, G, cq, giter);
          if (wave >= 4) {
              LAS float* scr = (LAS float*)(lds + RS_CONV_OFF + (wave - 4) * 16640); const int NCW = G * 4, cw = blk * 4 + (wave - 4); const int L = (TRD_N + NCW - 1) / NCW;
              for (; cq < L; ++cq) { const int item = cq * NCW + cw; if (item < TRD_N) { f32x4 v[16]; const TrDesc d = tr_decode(P, item); tr_issue(d, v, lane); tr_finish(d, v, scr, lane); } } } }
    } SEAM(4);
    if (IN(5)) { p5_combine(P, lane, wave, blk, G); } SEAM(5);
    if (IN(6)) {
        pg8::Gemm g{(const bf16*)(ws + WS_YMIX), (const bf16*)(ws + WS_WOUT), MTOK, 1024, 1024}; pg8::StaticOrder S; S.init(MTOK, 1024, G, blk);
        pg8::EpiResGate<false> E{P.in[0], XA, mod + 2048};
        pg8::gemm_phase<pg8::EpiResGate<false>, pg8::StaticOrder, true, true>(lds, g, S, E);
    } SEAM(6);
    if (IN(7)) { p7_router(P, lds, 0, XA, tid, lane, wave, blk, G); } SEAM(7);
    if (IN(9)) {
        const int MT = moe_tables(P, lds, 0, tid);
        pg8::Gemm g{Hb, (const bf16*)(ws + WS_W1T), ROWS_PAD, 2048, 1024, (const int*)(ws + WS_SIDXS), MTOK - 1};
        pg8::GroupedOrder S{MT, G, blk, 8, (const LAS int*)(lds + LDSCTL_OFF + LC_TILE)};
        pg8::EpiSwiglu E{(bf16*)(ws + WS_ACT), P.in[9]};
        pg8::gemm_phase<pg8::EpiSwiglu, pg8::GroupedOrder, true, true, true, true>(lds, g, S, E);
    } SEAM(9);
    if (IN(10)) {
        const int MT = moe_tables_again(P, lds, 0, tid);
        pg8::Gemm g{(const bf16*)(ws + WS_ACT), (const bf16*)(ws + WS_W2T), ROWS_PAD, 1024, 1024};
        pg8::GroupedOrder S{MT, G, blk, 4, (const LAS int*)(lds + LDSCTL_OFF + LC_TILE)};
        pg8::EpiMoeOut E{(bf16*)(ws + WS_EO), P.in[11]};
        pg8::gemm_phase<pg8::EpiMoeOut, pg8::GroupedOrder, true, true, false, true>(lds, g, S, E);
    } SEAM(10);
    if (IN(11)) { p11_moe_combine<false>(P, lds, 0, XA, XB, tid, lane, wave, blk, G); } SEAM(11);
    if (IN(12)) {
        pg8::Gemm g{Hb, (const bf16*)(ws + WS_WQKV), MTOK, 3072, 1024}; pg8::StaticOrder S; S.init(MTOK, 3072, G, blk);
        pg8::EpiBf16<0> E{(bf16*)(ws + WS_P), 1024, nullptr, 1024, (size_t)MTOK * 1024, QSCALE};
        pg8::gemm_phase<pg8::EpiBf16<0>, pg8::StaticOrder, true, true>(lds, g, S, E);
    } SEAM(12);
    if (IN(13)) { attn_phase(P, lds, tid, lane, wave, blk, G); } SEAM(13);
    if (IN(14)) {
        pg8::Gemm g{(const bf16*)(ws + WS_YMIX), (const bf16*)(ws + WS_WAO), MTOK, 1024, 1024}; pg8::StaticOrder S; S.init(MTOK, 1024, G, blk);
        pg8::EpiResGate<true> E{XB, XA, mod + 8 * 6144 + 2048};
        pg8::gemm_phase<pg8::EpiResGate<true>, pg8::StaticOrder, true, true>(lds, g, S, E);
    } SEAM(14);
    if (IN(15)) { p7_router(P, lds, 1, XA, tid, lane, wave, blk, G); } SEAM(15);
    if (IN(17)) {
        const int MT = moe_tables(P, lds, 1, tid);
        pg8::Gemm g{Hb, (const bf16*)(ws + WS_W1T) + (size_t)32 * 2048 * 1024, ROWS_PAD, 2048, 1024, (const int*)(ws + WS_SIDXS), MTOK - 1};
        pg8::GroupedOrder S{MT, G, blk, 8, (const LAS int*)(lds + LDSCTL_OFF + LC_TILE)};
        pg8::EpiSwiglu E{(bf16*)(ws + WS_ACT), P.in[9] + 32 * 2048};
        pg8::gemm_phase<pg8::EpiSwiglu, pg8::GroupedOrder, true, true, true, true>(lds, g, S, E);
    } SEAM(17);
    if (IN(18)) {
        const int MT = moe_tables_again(P, lds, 1, tid);
        pg8::Gemm g{(const bf16*)(ws + WS_ACT), (const bf16*)(ws + WS_W2T) + (size_t)32 * 1024 * 1024, ROWS_PAD, 1024, 1024};
        pg8::GroupedOrder S{MT, G, blk, 4, (const LAS int*)(lds + LDSCTL_OFF + LC_TILE)};
        pg8::EpiMoeOut E{(bf16*)(ws + WS_EO), P.in[11] + 32 * 1024};
        pg8::gemm_phase<pg8::EpiMoeOut, pg8::GroupedOrder, true, true, false, true>(lds, g, S, E);
    } SEAM(18);
    if (IN(19)) {
        p11_moe_combine<true>(P, lds, 1, XA, nullptr, tid, lane, wave, blk, G); }
#undef IN
#undef SEAM
}

extern "C" void kernel_launch(void* const* d_in, const int* in_sizes, int n_in, void* d_out, int out_size, void* d_ws, size_t ws_size, hipStream_t stream) {
    static int grid = 0;
    if (grid == 0) {
        if (n_in != 33 || out_size != MTOK * DM || ws_size < WS_END) { fprintf(stderr, "kernel_launch: unexpected problem (n_in %d, out %d, ws %zu)\n", n_in, out_size, ws_size); grid = -1; return; }
        int dev = 0, cus = 0, per_cu = 0;
        if (hipGetDevice(&dev) != hipSuccess || hipDeviceGetAttribute(&cus, hipDeviceAttributeMultiprocessorCount, dev) != hipSuccess) { grid = -1; return; }
        if (hipFuncSetAttribute((const void*)mk_fwd, hipFuncAttributeMaxDynamicSharedMemorySize, LDS_BYTES) != hipSuccess) { fprintf(stderr, "kernel_launch: hipFuncSetAttribute failed\n"); grid = -1; return; }
        if (hipOccupancyMaxActiveBlocksPerMultiprocessor(&per_cu, (const void*)mk_fwd, 512, LDS_BYTES) != hipSuccess || per_cu < 1) { fprintf(stderr, "kernel_launch: occupancy query says %d\n", per_cu); }
        (void)hipGetLastError();
        grid = cus;
    }
    if (grid < 0) return;
    (void)in_sizes;
    if (hipMemsetAsync((char*)d_ws + WS_CTL, 0, CTL_ZERO_BYTES, stream) != hipSuccess) return;
    Args a{};
    for (int i = 0; i < 33; ++i) a.p.in[i] = (const float*)d_in[i];
    a.p.out = (float*)d_out; a.p.ws = (unsigned char*)d_ws;
#if MK_N_LAUNCHES == 1
    a.ph_lo = 0; a.ph_hi = N_PHASES;
    hipLaunchKernelGGL(mk_fwd, dim3(grid), dim3(512), LDS_BYTES, stream, a);
#else
    for (int k = 0; k < N_PHASES; ++k) { a.ph_lo = k; a.ph_hi = k + 1; hipLaunchKernelGGL(mk_fwd, dim3(grid), dim3(512), LDS_BYTES, stream, a); }
#endif
}
```
